# Optimizing an MI355X kernel written in HIP

```python
import math
import jax, jax.numpy as jnp
from jax import lax
import numpy as np

D_MODEL = 1024
BATCH = 4
SEQ = 4096
DEPTH = 4

GRID_W = 64
CTX_LEN = 256
D_MIX = D_MODEL
HG_WIDTH = D_MIX // 2
HG_HEADS = 4
HG_DK = HG_WIDTH // HG_HEADS
RET_WIDTH = D_MIX // 4
RET_HEADS = 4
RET_DK = RET_WIDTH // RET_HEADS
S5_WIDTH = D_MIX - HG_WIDTH - RET_WIDTH
S5_GROUP_CH = 16
S5_GROUPS = S5_WIDTH // S5_GROUP_CH
S5_STATE = 64
IN_COLS = 5 * HG_WIDTH + 4 * RET_WIDTH + S5_WIDTH
CHUNK = 64
N_GROUPS = 4
EXPERTS_PER_GROUP = 4
N_EXPERTS = N_GROUPS * EXPERTS_PER_GROUP
TOP_K_INNER = 2
EXPERT_HIDDEN = D_MODEL // 2
ALPHA = (2.0 * DEPTH) ** 0.25
BETA = (8.0 * DEPTH) ** -0.25
LN_EPS = 1e-5
ROPE_BASE = 10000.0

kernel_name = 'hybrid_hgrn2_retention_s5_hmoe_dit_block'


def _layer_norm(x, g, b):
    xf = x.astype(jnp.float32)
    mu = jnp.mean(xf, -1, keepdims=True)
    var = jnp.mean(jnp.square(xf - mu), -1, keepdims=True)
    return ((xf - mu) * lax.rsqrt(var + LN_EPS) * g + b).astype(x.dtype)


def _rms_norm(o, g):
    return o * lax.rsqrt(jnp.mean(jnp.square(o), -1, keepdims=True) + LN_EPS) * g.astype(jnp.float32)


def _head_group_norm(o, g, b):
    mu = jnp.mean(o, -1, keepdims=True)
    var = jnp.mean(jnp.square(o - mu), -1, keepdims=True)
    return _merge((o - mu) * lax.rsqrt(var + LN_EPS)) * g.astype(jnp.float32) + b.astype(jnp.float32)


def _heads(a, n_heads):
    bsz, t, w = a.shape
    return a.reshape(bsz, t, n_heads, w // n_heads).transpose(0, 2, 1, 3)


def _merge(a):
    bsz, h, t, d = a.shape
    return a.transpose(0, 2, 1, 3).reshape(bsz, t, h * d)


def _split_columns(p):
    sizes = [HG_WIDTH] * 5 + [RET_WIDTH] * 4 + [S5_WIDTH]
    cuts = [int(v) for v in np.cumsum(sizes)[:-1]]
    return jnp.split(p, cuts, axis=-1)


def _rotate_half(z, pos):
    m = z.shape[-1] // 2
    inv = ROPE_BASE ** (-jnp.arange(m, dtype=jnp.float32) / m)
    ang = pos.astype(jnp.float32)[:, None] * inv
    cos, sin = jnp.cos(ang), jnp.sin(ang)
    z1, z2 = z[..., :m], z[..., m:]
    return jnp.concatenate([z1 * cos - z2 * sin, z1 * sin + z2 * cos], -1)


def _axial_rotary(a, rows, cols):
    n = a.shape[-1] // 2
    return jnp.concatenate([_rotate_half(a[..., :n], rows), _rotate_half(a[..., n:], cols)], -1)


def _chunk_gated_scan(q, k, v, log_f, s0):
    bsz, h, t, dk = q.shape
    dv = v.shape[-1]
    n = t // CHUNK

    def chunks(a):
        return jnp.moveaxis(a.reshape(bsz, h, n, CHUNK, a.shape[-1]), 2, 0)

    lower = jnp.tril(jnp.ones((CHUNK, CHUNK), dtype=bool))[:, :, None]

    def step(s, blk):
        qc, kc, vc, fc = blk
        cum = jnp.cumsum(fc, axis=2)
        inter = jnp.einsum('bhik,bhkv->bhiv', qc * jnp.exp(cum), s)
        rel = jnp.where(lower, cum[:, :, :, None, :] - cum[:, :, None, :, :], -jnp.inf)
        scores = jnp.einsum('bhik,bhjk,bhijk->bhij', qc, kc, jnp.exp(rel))
        o = inter + jnp.einsum('bhij,bhjv->bhiv', scores, vc)
        tail = cum[:, :, -1:, :]
        s = jnp.exp(tail[:, :, 0, :, None]) * s + jnp.einsum('bhjk,bhjv->bhkv', kc * jnp.exp(tail - cum), vc)
        return s, o

    s_fin, o = lax.scan(step, s0, (chunks(q), chunks(k), chunks(v), chunks(log_f)))
    return jnp.moveaxis(o, 0, 2).reshape(bsz, h, t, dv), s_fin


def _bidir_gated_recurrence(ctx_in, lat_in):
    q_c, v_c, gates_c = ctx_in
    q_l, v_l, gates_l = lat_in
    bsz, h, _, dk = q_c.shape
    s0 = jnp.zeros((bsz, h, dk, v_c.shape[-1]), jnp.float32)
    o_c, o_l = 0.0, 0.0
    for d in range(2):
        flip = (lambda a: jnp.flip(a, axis=2)) if d else (lambda a: a)
        k_c, lf_c = gates_c[d]
        k_l, lf_l = gates_l[d]
        oc, s_ctx = _chunk_gated_scan(flip(q_c), flip(k_c), flip(v_c), flip(lf_c), s0)
        ol, _ = _chunk_gated_scan(flip(q_l), flip(k_l), flip(v_l), flip(lf_l), s_ctx)
        o_c = o_c + flip(oc)
        o_l = o_l + flip(ol)
    return o_c, o_l


def _s5_discretize(lam_re, lam_im, log_dt, b_re, b_im):
    f32 = jnp.float32
    lam_re = jnp.minimum(lam_re.astype(f32), -1e-4)
    lam_im = lam_im.astype(f32)
    dt = jnp.exp(log_dt.astype(f32))[:, None]
    mag = jnp.exp(dt * lam_re)
    abar_re, abar_im = mag * jnp.cos(dt * lam_im), mag * jnp.sin(dt * lam_im)
    den = jnp.square(lam_re) + jnp.square(lam_im)
    nr, ni = abar_re - 1.0, abar_im
    coef_re = ((nr * lam_re + ni * lam_im) / den)[..., None]
    coef_im = ((ni * lam_re - nr * lam_im) / den)[..., None]
    b_re, b_im = b_re.astype(f32), b_im.astype(f32)
    bbar_re = coef_re * b_re - coef_im * b_im
    bbar_im = coef_re * b_im + coef_im * b_re
    return abar_re, abar_im, bbar_re, bbar_im


def _s5_scan(u, abar_re, abar_im, bbar_re, bbar_im, h0_re, h0_im):
    bu_re = jnp.einsum('btgc,gpc->btgp', u, bbar_re)
    bu_im = jnp.einsum('btgc,gpc->btgp', u, bbar_im)
    bu_re = bu_re.at[:, 0].add(abar_re * h0_re - abar_im * h0_im)
    bu_im = bu_im.at[:, 0].add(abar_re * h0_im + abar_im * h0_re)
    a_re = jnp.broadcast_to(abar_re, bu_re.shape)
    a_im = jnp.broadcast_to(abar_im, bu_re.shape)

    def combine(e1, e2):
        a1r, a1i, b1r, b1i = e1
        a2r, a2i, b2r, b2i = e2
        return (a2r * a1r - a2i * a1i, a2r * a1i + a2i * a1r,
                a2r * b1r - a2i * b1i + b2r, a2r * b1i + a2i * b1r + b2i)

    _, _, h_re, h_im = lax.associative_scan(combine, (a_re, a_im, bu_re, bu_im), axis=1)
    return h_re, h_im


def _s5_bidirectional(u_c, u_l, lam_re, lam_im, log_dt, b_re, b_im, c_re, c_im):
    bsz = u_c.shape[0]
    gc = lambda u: u.reshape(u.shape[0], u.shape[1], S5_GROUPS, S5_GROUP_CH)
    ug_c, ug_l = gc(u_c), gc(u_l)
    zeros = jnp.zeros((bsz, S5_GROUPS, S5_STATE), jnp.float32)
    y_c, y_l = 0.0, 0.0
    for d in range(2):
        flip = (lambda a: jnp.flip(a, axis=1)) if d else (lambda a: a)
        disc = _s5_discretize(lam_re[d], lam_im[d], log_dt[d], b_re[d], b_im[d])
        hc_re, hc_im = _s5_scan(flip(ug_c), *disc, zeros, zeros)
        hl_re, hl_im = _s5_scan(flip(ug_l), *disc, hc_re[:, -1], hc_im[:, -1])
        cr, ci = c_re[d].astype(jnp.float32), c_im[d].astype(jnp.float32)
        read = lambda hr, hi: jnp.einsum('btgp,gcp->btgc', hr, cr) - jnp.einsum('btgp,gcp->btgc', hi, ci)
        y_c = y_c + flip(read(hc_re, hc_im))
        y_l = y_l + flip(read(hl_re, hl_im))
    return y_c.reshape(u_c.shape), y_l.reshape(u_l.shape)


def _hybrid_mixer(h_c, h_l, rows, cols, w_in, hg_lb, hg_norm_g, ret_decay_raw, ret_gn_g, ret_gn_b,
                  s5_lam_re, s5_lam_im, s5_log_dt, s5_b_re, s5_b_im, s5_c_re, s5_c_im, s5_d, s5_glu_w, s5_glu_b,
                  w_out):
    f32 = jnp.float32
    parts_c = _split_columns((h_c @ w_in).astype(f32))
    parts_l = _split_columns((h_l @ w_in).astype(f32))
    lb = hg_lb.astype(f32).reshape(2, HG_HEADS, 1, HG_DK)
    log_gamma = jax.nn.log_sigmoid(ret_decay_raw.astype(f32))

    def hgrn2_inputs(p):
        q = jax.nn.silu(_heads(p[0], HG_HEADS))
        v = _heads(p[1], HG_HEADS)
        gates = []
        for d in range(2):
            f = lb[d] + (1.0 - lb[d]) * jax.nn.sigmoid(_heads(p[3 + d], HG_HEADS))
            gates.append((1.0 - f, jnp.log(f)))
        return q, v, gates

    def retention_inputs(p, rotate):
        q = _heads(p[5], RET_HEADS)
        k = _heads(p[6], RET_HEADS) * RET_DK ** -0.5
        v = _heads(p[7], RET_HEADS)
        if rotate:
            q, k = _axial_rotary(q, rows, cols), _axial_rotary(k, rows, cols)
        gates = [(k, jnp.broadcast_to(log_gamma[d][:, None, None], k.shape)) for d in range(2)]
        return q, v, gates

    o_hg_c, o_hg_l = _bidir_gated_recurrence(hgrn2_inputs(parts_c), hgrn2_inputs(parts_l))
    o_rt_c, o_rt_l = _bidir_gated_recurrence(retention_inputs(parts_c, False), retention_inputs(parts_l, True))
    y5_c, y5_l = _s5_bidirectional(parts_c[9], parts_l[9], s5_lam_re, s5_lam_im, s5_log_dt,
                                   s5_b_re, s5_b_im, s5_c_re, s5_c_im)

    def merge_groups(p, o_hg, o_rt, y5):
        hg = _merge(_rms_norm(o_hg, hg_norm_g)) * jax.nn.silu(p[2])
        rt = _head_group_norm(o_rt, ret_gn_g, ret_gn_b) * jax.nn.silu(p[8])
        s5 = jax.nn.gelu(y5 + s5_d.astype(f32) * p[9])
        s5 = s5 * jax.nn.sigmoid(s5 @ s5_glu_w.astype(f32) + s5_glu_b.astype(f32))
        return jnp.concatenate([hg, rt, s5], -1).astype(w_out.dtype) @ w_out

    return merge_groups(parts_c, o_hg_c, o_rt_c, y5_c), merge_groups(parts_l, o_hg_l, o_rt_l, y5_l)


def _hier_moe(h, rg_w, rg_b, re_w, re_b, w_gate, w_up, w_down):
    f32 = jnp.float32
    g_prob = jax.nn.softmax((h @ rg_w + rg_b).astype(f32), -1)
    g_p, g_idx = lax.top_k(g_prob, 1)
    e_all = (jnp.einsum('nd,dge->nge', h, re_w) + re_b).astype(f32)
    e_logits = jnp.take_along_axis(e_all, g_idx[:, :, None], axis=1)[:, 0]
    e_top, e_idx = lax.top_k(e_logits, TOP_K_INNER)
    e_w = jax.nn.softmax(e_top, -1) * g_p
    flat_idx = g_idx * EXPERTS_PER_GROUP + e_idx
    combine = jnp.einsum('nk,nke->ne', e_w, jax.nn.one_hot(flat_idx, N_EXPERTS, dtype=f32)).astype(h.dtype)
    y = jnp.zeros_like(h)
    for e in range(N_EXPERTS):
        a = h @ w_gate[e]
        b = h @ w_up[e]
        y = y + combine[:, e:e + 1] * ((jax.nn.silu(a) * b) @ w_down[e])
    return y


def setup_inputs(seed: int = 0) -> dict:
    key = jax.random.key(seed)
    ks = jax.random.split(key, 40)
    f32 = jnp.float32

    def nrm(i, shape, scale):
        return scale * jax.random.normal(ks[i], shape, f32)

    s5_shape = (DEPTH, 2, S5_GROUPS, S5_STATE)
    n_state = jnp.arange(S5_STATE, dtype=f32)
    ret_init = jnp.log(2.0 ** (5.0 + jnp.arange(RET_HEADS, dtype=f32)) - 1.0)
    return {
        'x': nrm(0, (BATCH, SEQ, D_MODEL), 1.0),
        'c': nrm(1, (BATCH, D_MODEL), 1.0),
        'ctx': nrm(2, (BATCH, CTX_LEN, D_MODEL), 1.0),
        'c_ctx': nrm(3, (D_MODEL,), 1.0),
        'w_mod': nrm(4, (DEPTH, D_MODEL, 6 * D_MODEL), D_MODEL ** -0.5),
        'b_mod': nrm(5, (DEPTH, 6 * D_MODEL), 0.02),
        'w_in': nrm(6, (DEPTH, D_MODEL, IN_COLS), D_MODEL ** -0.5),
        'hg_lb_raw': nrm(7, (DEPTH, 2, HG_WIDTH), 0.5),
        'hg_norm_g': 1.0 + nrm(8, (DEPTH, HG_DK), 0.02),
        'ret_decay_raw': ret_init + nrm(9, (DEPTH, 2, RET_HEADS), 0.05),
        'ret_gn_g': 1.0 + nrm(10, (DEPTH, RET_WIDTH), 0.02),
        'ret_gn_b': nrm(11, (DEPTH, RET_WIDTH), 0.02),
        's5_lam_re': -0.5 + nrm(12, s5_shape, 0.01),
        's5_lam_im': math.pi * n_state + nrm(13, s5_shape, 0.01),
        's5_log_dt': jax.random.uniform(ks[14], (DEPTH, 2, S5_GROUPS), f32, math.log(1e-3), math.log(1e-1)),
        's5_b_re': nrm(15, (DEPTH, 2, S5_GROUPS, S5_STATE, S5_GROUP_CH), (2.0 * S5_GROUP_CH) ** -0.5),
        's5_b_im': nrm(16, (DEPTH, 2, S5_GROUPS, S5_STATE, S5_GROUP_CH), (2.0 * S5_GROUP_CH) ** -0.5),
        's5_c_re': nrm(17, (DEPTH, 2, S5_GROUPS, S5_GROUP_CH, S5_STATE), S5_STATE ** -0.5),
        's5_c_im': nrm(18, (DEPTH, 2, S5_GROUPS, S5_GROUP_CH, S5_STATE), S5_STATE ** -0.5),
        's5_d': nrm(19, (DEPTH, S5_WIDTH), 1.0),
        's5_glu_w': nrm(20, (DEPTH, S5_WIDTH, S5_WIDTH), S5_WIDTH ** -0.5),
        's5_glu_b': nrm(21, (DEPTH, S5_WIDTH), 0.01),
        'w_out': nrm(22, (DEPTH, D_MIX, D_MODEL), BETA * D_MIX ** -0.5),
        'ln1_g': 1.0 + nrm(23, (DEPTH, D_MODEL), 0.02),
        'ln1_b': nrm(24, (DEPTH, D_MODEL), 0.02),
        'ln2_g': 1.0 + nrm(25, (DEPTH, D_MODEL), 0.02),
        'ln2_b': nrm(26, (DEPTH, D_MODEL), 0.02),
        'rg_w': nrm(27, (DEPTH, D_MODEL, N_GROUPS), D_MODEL ** -0.5),
        'rg_b': nrm(28, (DEPTH, N_GROUPS), 0.01),
        're_w': nrm(29, (DEPTH, D_MODEL, N_GROUPS, EXPERTS_PER_GROUP), D_MODEL ** -0.5),
        're_b': nrm(30, (DEPTH, N_GROUPS, EXPERTS_PER_GROUP), 0.01),
        'exp_w_gate': nrm(31, (DEPTH, N_EXPERTS, D_MODEL, EXPERT_HIDDEN), D_MODEL ** -0.5),
        'exp_w_up': nrm(32, (DEPTH, N_EXPERTS, D_MODEL, EXPERT_HIDDEN), D_MODEL ** -0.5),
        'exp_w_down': nrm(33, (DEPTH, N_EXPERTS, EXPERT_HIDDEN, D_MODEL), BETA * EXPERT_HIDDEN ** -0.5),
    }


def reference(x, c, ctx, c_ctx, w_mod, b_mod, w_in, hg_lb_raw, hg_norm_g, ret_decay_raw, ret_gn_g, ret_gn_b,
              s5_lam_re, s5_lam_im, s5_log_dt, s5_b_re, s5_b_im, s5_c_re, s5_c_im, s5_d, s5_glu_w, s5_glu_b,
              w_out, ln1_g, ln1_b, ln2_g, ln2_b, rg_w, rg_b, re_w, re_b, exp_w_gate, exp_w_up, exp_w_down):
    bsz, t, d_model = x.shape
    ctx_len = ctx.shape[1]
    ROWS = t // GRID_W
    rows = jnp.repeat(jnp.arange(ROWS, dtype=jnp.int32), GRID_W)
    cols = jnp.tile(jnp.arange(GRID_W, dtype=jnp.int32), ROWS)
    hg_lb = jnp.cumsum(jax.nn.softmax(hg_lb_raw.astype(jnp.float32), axis=0), axis=0)
    hg_lb = hg_lb - hg_lb[:1]
    sc_lat = jax.nn.silu(c)
    sc_ctx = jax.nn.silu(c_ctx)
    for l in range(DEPTH):
        last = l == DEPTH - 1
        sh1, s1, g1, sh2, s2, g2 = jnp.split((sc_lat @ w_mod[l] + b_mod[l])[:, None, :], 6, axis=-1)
        sh1c, s1c, g1c, sh2c, s2c, g2c = jnp.split(sc_ctx @ w_mod[l] + b_mod[l], 6, axis=-1)
        y_c, y_l = _hybrid_mixer(ctx * (1.0 + s1c) + sh1c, x * (1.0 + s1) + sh1, rows, cols, w_in[l], hg_lb[l],
                                 hg_norm_g[l], ret_decay_raw[l], ret_gn_g[l], ret_gn_b[l], s5_lam_re[l],
                                 s5_lam_im[l], s5_log_dt[l], s5_b_re[l], s5_b_im[l], s5_c_re[l], s5_c_im[l],
                                 s5_d[l], s5_glu_w[l], s5_glu_b[l], w_out[l])
        x = _layer_norm(ALPHA * x + g1 * y_l, ln1_g[l], ln1_b[l])
        h_l = x * (1.0 + s2) + sh2
        if last:
            tokens = h_l
        else:
            ctx = _layer_norm(ALPHA * ctx + g1c * y_c, ln1_g[l], ln1_b[l])
            tokens = jnp.concatenate([ctx * (1.0 + s2c) + sh2c, h_l], axis=1)
        y = _hier_moe(tokens.reshape(-1, d_model), rg_w[l], rg_b[l], re_w[l], re_b[l],
                      exp_w_gate[l], exp_w_up[l], exp_w_down[l]).reshape(bsz, -1, d_model)
        x = _layer_norm(ALPHA * x + g2 * y[:, y.shape[1] - t:], ln2_g[l], ln2_b[l])
        if not last:
            ctx = _layer_norm(ALPHA * ctx + g2c * y[:, :ctx_len], ln2_g[l], ln2_b[l])
    return x
```

```cpp
#include <hip/hip_runtime.h>
#include <cstdio>
#include <cstdint>
namespace pg8 {
#define PG8_LAS __attribute__((address_space(3)))
typedef unsigned short bf16_t;
typedef short bf16x8 __attribute__((ext_vector_type(8)));
typedef float f32x4 __attribute__((ext_vector_type(4)));
typedef unsigned u32x4 __attribute__((ext_vector_type(4)));
constexpr int BM = 256, BK = 64, HALF = 128, HTB = HALF * BK * 2  , STAGE_BYTES = 8 * HTB, NXCD = 8, WGM = 8;

__host__ __device__ __forceinline__ int lds_byte(int r, int c) { const int st = (r >> 4) * 2 + (c >> 5), rr = r & 15, cc = c & 31, ob = rr * 64 + cc * 2; return st * 1024 + (ob ^ (((ob >> 9) & 1) << 5)); }
__host__ __device__ __forceinline__ void stage_rc(int b, int& R, int& C) { const int st = b / 1024, sb = b % 1024, swz = sb ^ (((sb >> 9) & 1) << 5); R = (st >> 1) * 16 + swz / 64; C = (st & 1) * 32 + (swz % 64) / 2; }
__host__ __device__ __forceinline__ int perm32(int rho) { const int n = rho >> 4, i = rho & 15; return 8 * (i >> 2) + 4 * n + (i & 3); }

struct Unit { int pm, pn; };
struct Gemm { const bf16_t* A; const bf16_t* Bt; int M, N, K; };

struct StaticOrder {
    int nM, nN, nwg, G, c;
    __host__ __device__ void init(int M, int N, int G_, int c_) { nM = M / BM; nN = N / BM; nwg = nM * nN; G = G_; c = c_; }
    __host__ __device__ bool next(int i, Unit& u) const {
        const long L = (long)i * G + c; if (L >= nwg) return false;
        int wgid = (int)L; { const int q = nwg / NXCD, r = nwg % NXCD, xcd = wgid % NXCD, off = wgid / NXCD; wgid = (xcd < r ? xcd * (q + 1) : r * (q + 1) + (xcd - r) * q) + off; }
        const int nig = WGM * nN, gid = wgid / nig, fm = gid * WGM, gsz = (nM - fm) < WGM ? (nM - fm) : WGM;
        u.pm = fm + ((wgid % nig) % gsz); u.pn = (wgid % nig) / gsz; return true;
    }
    __device__ __forceinline__ void a_ready(const Unit&) const {}
    __device__ __forceinline__ void done(const Unit&) const {}
};

__device__ __forceinline__ unsigned cvt_pk_bf16(float lo, float hi) { unsigned r; asm volatile("v_cvt_pk_bf16_f32 %0, %1, %2" : "=v"(r) : "v"(lo), "v"(hi)); return r; }
template <class Epi, class Sched, bool ALIGN_EPI = false, bool SP2 = false>
__device__ __forceinline__ void gemm_phase(PG8_LAS unsigned char* lds, const Gemm g, const Sched& S, const Epi& E) {
    int tid_ = threadIdx.x; asm volatile("" : "+v"(tid_));
    const int tid = tid_, wid = __builtin_amdgcn_readfirstlane(tid >> 6), lane = tid & 63, wr = wid >> 2, wc = wid & 3, fr = lane & 15, fq = lane >> 4;
    const int K = g.K, nt = K / BK;
    unsigned voffA[2], voffB[2];
#pragma unroll
    for (int i = 0; i < 2; ++i) { int R, C; stage_rc(tid * 16 + i * 8192, R, C); const int Rb = Epi::PERM ? ((R & ~31) + perm32(R & 31)) : R;
        voffA[i] = (unsigned)(R * K + C) * 2u; voffB[i] = (unsigned)(Rb * K + C) * 2u; }
    const size_t kstep = (size_t)(BK * 2);
    const size_t hstep = (size_t)HALF * K * 2;
    const size_t tstep = 2 * hstep;
    const unsigned ldsw = (unsigned)wid * 1024u;
    const int aoff = lds_byte(wr * 64 + fr, fq * 8), boff = lds_byte(wc * 32 + fr, fq * 8);
#define PG8_SA(b, h) (((b) * 2 + (h)) * HTB)
#define PG8_SB(b, h) ((4 + (b) * 2 + (h)) * HTB)
#define PG8_STAGE(bufoff, gbase, voff) do { _Pragma("unroll") for (int _i = 0; _i < 2; ++_i) \
        __builtin_amdgcn_global_load_lds((const unsigned*)((const char*)(gbase) + (voff)[_i]), (PG8_LAS unsigned*)(lds + (bufoff) + ldsw + _i * 8192), 16, 0, 0); } while (0)
#define PG8_LDA(dst, b, h) do { _Pragma("unroll") for (int m = 0; m < 4; ++m) _Pragma("unroll") for (int k = 0; k < 2; ++k) dst[m][k] = *(const PG8_LAS bf16x8*)(lds + PG8_SA(b, h) + aoff + m * 2048 + k * 1024); } while (0)
#define PG8_LDB(dst, b, h) do { _Pragma("unroll") for (int n = 0; n < 2; ++n) _Pragma("unroll") for (int k = 0; k < 2; ++k) dst[n][k] = *(const PG8_LAS bf16x8*)(lds + PG8_SB(b, h) + boff + n * 2048 + k * 1024); } while (0)
#define PG8_MMA(ai, bj, At, Bt) do { __builtin_amdgcn_s_setprio(1); _Pragma("unroll") for (int m = 0; m < 4; ++m) _Pragma("unroll") for (int n = 0; n < 2; ++n) _Pragma("unroll") for (int k = 0; k < 2; ++k) \
        acc[ai][bj][m][n] = __builtin_amdgcn_mfma_f32_16x16x32_bf16(Bt[n][k], At[m][k], acc[ai][bj][m][n], 0, 0, 0); __builtin_amdgcn_s_setprio(0); } while (0)
#define PG8_WAIT_V(n) asm volatile("s_waitcnt vmcnt(" #n ")" ::: "memory")
#define PG8_WAIT_L(n) asm volatile("s_waitcnt lgkmcnt(" #n ")" ::: "memory")
#define PG8_BAR __builtin_amdgcn_s_barrier()
#define PG8_SCHED __builtin_amdgcn_sched_barrier(0)
    Unit cur, nxt; int ui = 0;
    if (!S.next(0, cur)) return;
    f32x4 acc[2][2][4][2];
#pragma unroll
    for (int a = 0; a < 2; ++a)
#pragma unroll
        for (int b = 0; b < 2; ++b)
#pragma unroll
            for (int m = 0; m < 4; ++m)
#pragma unroll
                for (int n = 0; n < 2; ++n) acc[a][b][m][n] = (f32x4){0.f, 0.f, 0.f, 0.f};
    bf16x8 At[4][2], B0[2][2], B1[2][2];
    const char* cA = (const char*)g.A + (size_t)cur.pm * tstep; const char* cB = (const char*)g.Bt + (size_t)cur.pn * tstep;
    S.a_ready(cur);
    if constexpr (SP2) {
        PG8_STAGE(PG8_SB(0, 0), cB, voffB); PG8_STAGE(PG8_SB(0, 1), cB + hstep, voffB); PG8_STAGE(PG8_SA(0, 0), cA, voffA); PG8_STAGE(PG8_SA(0, 1), cA + hstep, voffA);
        if (wr == 1) PG8_BAR;
        PG8_WAIT_V(2); PG8_BAR;
        PG8_STAGE(PG8_SB(1, 0), cB + kstep, voffB); PG8_STAGE(PG8_SA(1, 0), cA + kstep, voffA); PG8_STAGE(PG8_SB(1, 1), cB + hstep + kstep, voffB);
        PG8_WAIT_V(6); PG8_BAR;
    } else {
        PG8_STAGE(PG8_SB(0, 0), cB, voffB); PG8_STAGE(PG8_SA(0, 0), cA, voffA); PG8_STAGE(PG8_SB(0, 1), cB + hstep, voffB); PG8_STAGE(PG8_SA(0, 1), cA + hstep, voffA);
        if (wr == 1) PG8_BAR;
        PG8_WAIT_V(4); PG8_BAR;
        PG8_STAGE(PG8_SB(1, 0), cB + kstep, voffB); PG8_STAGE(PG8_SA(1, 0), cA + kstep, voffA); PG8_STAGE(PG8_SB(1, 1), cB + hstep + kstep, voffB);
        PG8_WAIT_V(6); PG8_BAR;
    }
    for (;;) {
        const bool has_next = S.next(ui + 1, nxt);
        const char* nA = has_next ? (const char*)g.A + (size_t)nxt.pm * tstep : cA; const char* nB = has_next ? (const char*)g.Bt + (size_t)nxt.pn * tstep : cB;
        for (int t = 0; t < nt; t += 2) {
            const bool last = (t == nt - 2);
            const char* a1 = cA + (size_t)(t + 1) * kstep;
            const char* a2 = last ? nA : cA + (size_t)(t + 2) * kstep; const char* b2 = last ? nB : cB + (size_t)(t + 2) * kstep;
            const char* a3 = a2 + kstep; const char* b3 = b2 + kstep;
            if (last && has_next) S.a_ready(nxt);
            if constexpr (SP2) {
            PG8_LDB(B0, 0, 0); PG8_LDB(B1, 0, 1); PG8_SCHED; PG8_LDA(At, 0, 0); PG8_STAGE(PG8_SA(1, 1), a1 + hstep, voffA);
            PG8_WAIT_V(8); PG8_WAIT_L(0); PG8_BAR; PG8_MMA(0, 0, At, B0); PG8_MMA(0, 1, At, B1); PG8_BAR; PG8_SCHED;
            PG8_LDA(At, 0, 1); PG8_STAGE(PG8_SB(0, 0), b2, voffB); PG8_STAGE(PG8_SB(0, 1), b2 + hstep, voffB); PG8_STAGE(PG8_SA(0, 0), a2, voffA);
            PG8_WAIT_V(8); PG8_WAIT_L(0); PG8_BAR; PG8_MMA(1, 0, At, B0); PG8_MMA(1, 1, At, B1); PG8_BAR; PG8_SCHED;
            PG8_LDB(B0, 1, 0); PG8_LDB(B1, 1, 1); PG8_SCHED; PG8_LDA(At, 1, 0); PG8_STAGE(PG8_SA(0, 1), a2 + hstep, voffA);
            PG8_WAIT_V(8); PG8_WAIT_L(0); PG8_BAR; PG8_MMA(0, 0, At, B0); PG8_MMA(0, 1, At, B1); PG8_BAR; PG8_SCHED;
            PG8_LDA(At, 1, 1); PG8_STAGE(PG8_SB(1, 0), b3, voffB); PG8_STAGE(PG8_SB(1, 1), b3 + hstep, voffB); PG8_STAGE(PG8_SA(1, 0), a3, voffA);
            PG8_WAIT_V(8); PG8_WAIT_L(0); PG8_BAR; PG8_MMA(1, 0, At, B0); PG8_MMA(1, 1, At, B1); PG8_BAR; PG8_SCHED;
            } else {
            PG8_LDB(B0, 0, 0); PG8_SCHED; PG8_LDA(At, 0, 0); PG8_STAGE(PG8_SA(1, 1), a1 + hstep, voffA);
            PG8_WAIT_L(8); PG8_BAR; PG8_WAIT_L(0); PG8_MMA(0, 0, At, B0); PG8_BAR; PG8_SCHED;
            PG8_LDB(B1, 0, 1); PG8_STAGE(PG8_SB(0, 0), b2, voffB);
            PG8_BAR; PG8_WAIT_L(0); PG8_MMA(0, 1, At, B1); PG8_BAR;
            PG8_LDA(At, 0, 1); PG8_STAGE(PG8_SA(0, 0), a2, voffA);
            PG8_BAR; PG8_WAIT_L(0); PG8_MMA(1, 0, At, B0); PG8_BAR; PG8_SCHED;
            PG8_STAGE(PG8_SB(0, 1), b2 + hstep, voffB);
            PG8_WAIT_V(6); PG8_BAR; PG8_MMA(1, 1, At, B1); PG8_BAR;
            PG8_LDB(B0, 1, 0); PG8_SCHED; PG8_LDA(At, 1, 0); PG8_STAGE(PG8_SA(0, 1), a2 + hstep, voffA);
            PG8_WAIT_L(8); PG8_BAR; PG8_WAIT_L(0); PG8_MMA(0, 0, At, B0); PG8_BAR; PG8_SCHED;
            PG8_LDB(B1, 1, 1); PG8_STAGE(PG8_SB(1, 0), b3, voffB);
            PG8_BAR; PG8_WAIT_L(0); PG8_MMA(0, 1, At, B1); PG8_BAR;
            PG8_LDA(At, 1, 1); PG8_STAGE(PG8_SA(1, 0), a3, voffA);
            PG8_BAR; PG8_WAIT_L(0); PG8_MMA(1, 0, At, B0); PG8_BAR; PG8_SCHED;
            PG8_STAGE(PG8_SB(1, 1), b3 + hstep, voffB);
            PG8_WAIT_V(6); PG8_BAR; PG8_MMA(1, 1, At, B1); PG8_BAR;
            }
        }
        if constexpr (ALIGN_EPI) { if (wr == 0) PG8_BAR; }
        if constexpr (!Epi::AFTER_DRAIN) { E(acc, cur, wr, wc, fr, fq); S.done(cur); }
        if (!has_next) break;
#pragma unroll
        for (int a = 0; a < 2; ++a)
#pragma unroll
            for (int b = 0; b < 2; ++b)
#pragma unroll
                for (int m = 0; m < 4; ++m)
#pragma unroll
                    for (int n = 0; n < 2; ++n) acc[a][b][m][n] = (f32x4){0.f, 0.f, 0.f, 0.f};
        cur = nxt; cA = nA; cB = nB; ++ui;
        if constexpr (ALIGN_EPI) { if (wr == 1) PG8_BAR; }
    }
    PG8_WAIT_V(0);
    if constexpr (!ALIGN_EPI) { if (wr == 0) PG8_BAR; }
    PG8_BAR;
    if constexpr (Epi::AFTER_DRAIN) { E.fused(acc, cur, wr, wc, fr, fq, lds, wid, lane); S.done(cur); }
#undef PG8_SA
#undef PG8_SB
#undef PG8_STAGE
#undef PG8_LDA
#undef PG8_LDB
#undef PG8_MMA
#undef PG8_WAIT_V
#undef PG8_WAIT_L
#undef PG8_BAR
#undef PG8_SCHED
}
}
#define XB_TMO      128
#define XB_XCNT(j)  (256  + 64 * (j))
#define XB_XSUB(j)  (1280 + 64 * (j))
#define XB_XGEN(j)  (2304 + 64 * (j))
#define XB_TOP      3328
#define XB_TOPGEN   3392
#define XCD_BAR_WORDS 3456
#define XB_SPIN_CAP (1u << 18)
#define LAS __attribute__((address_space(3)))

__device__ __forceinline__ unsigned xb_ld(unsigned* p)              { return __hip_atomic_load(p, __ATOMIC_RELAXED, __HIP_MEMORY_SCOPE_AGENT); }
__device__ __forceinline__ unsigned xb_add(unsigned* p, unsigned v) { return __hip_atomic_fetch_add(p, v, __ATOMIC_RELAXED, __HIP_MEMORY_SCOPE_AGENT); }
__device__ __forceinline__ unsigned xb_xcc_id() { return (unsigned)__builtin_amdgcn_s_getreg((3 << 11) | 20) & 0xFu; }
#define XB_SPIN(cond, bar) do { unsigned _sp = 0; while (cond) { __builtin_amdgcn_s_sleep(1); \
    if ((++_sp & 255u) == 0u) { if (xb_ld(&(bar)[XB_TMO])) break; if (_sp > XB_SPIN_CAP) { atomicAdd(&(bar)[XB_TMO], 1u); break; } } } } while (0)

struct XcdBarrier {
    unsigned* bar; unsigned x;
    volatile LAS unsigned* st;
};

__device__ __forceinline__ XcdBarrier xcd_barrier_post(unsigned* bar, volatile LAS unsigned* st) {
    XcdBarrier b; b.bar = bar; b.x = xb_xcc_id(); b.st = st;
    if (threadIdx.x == 0) (void)xb_add(&bar[XB_XCNT(b.x)], 1u);
    return b;
}
__device__ __forceinline__ void xcd_barrier_complete(unsigned* bar, unsigned x, unsigned& nloc, unsigned& nx) {
    const unsigned G = gridDim.x * gridDim.y * gridDim.z;
    unsigned sum, cnt, mine, sp = 0u;
    for (;;) {
        sum = 0u; cnt = 0u; mine = 0u;
#pragma unroll
        for (unsigned j = 0; j < 16; ++j) { const unsigned c = xb_ld(&bar[XB_XCNT(j)]); sum += c; cnt += (c > 0u) ? 1u : 0u; mine = (j == x) ? c : mine; }
        if (sum == G) break;
        __builtin_amdgcn_s_sleep(1);
        if ((++sp & 255u) == 0u) { if (xb_ld(&bar[XB_TMO])) break; if (sp > XB_SPIN_CAP) { atomicAdd(&bar[XB_TMO], 1u); break; } }
    }
    nloc = mine > 0u ? mine : 1u; nx = cnt > 0u ? cnt : 1u;
}

__device__ __forceinline__ void xcd_barrier(const XcdBarrier& b) {
    asm volatile("s_waitcnt vmcnt(0)" ::: "memory");
    __syncthreads();
    if (threadIdx.x == 0) {
        unsigned* bar = b.bar;
        __builtin_amdgcn_s_waitcnt(0);
        unsigned nloc = b.st[0], nx = b.st[1];
        if (nloc == 0u) { xcd_barrier_complete(bar, b.x, nloc, nx); b.st[0] = nloc; b.st[1] = nx; }
        const unsigned old = xb_add(&bar[XB_XSUB(b.x)], 1u);
        const unsigned gen = old / nloc;
        if (old + 1u == (gen + 1u) * nloc) {
            __builtin_amdgcn_fence(__ATOMIC_RELEASE, "agent");
            asm volatile("s_waitcnt vmcnt(0)" ::: "memory");
            const unsigned og = xb_add(&bar[XB_TOP], 1u);
            const unsigned tg = og / nx;
            if (og + 1u == (tg + 1u) * nx) xb_add(&bar[XB_TOPGEN], 1u);
            else XB_SPIN(xb_ld(&bar[XB_TOPGEN]) == tg, bar);
            __builtin_amdgcn_fence(__ATOMIC_ACQUIRE, "agent");
            xb_add(&bar[XB_XGEN(b.x)], 1u);
            asm volatile("s_waitcnt vmcnt(0)" ::: "memory");
        } else {
            XB_SPIN(xb_ld(&bar[XB_XGEN(b.x)]) == gen, bar);
            __builtin_amdgcn_fence(__ATOMIC_ACQUIRE, "agent");
            asm volatile("s_waitcnt vmcnt(0)" ::: "memory");
        }
    }
    __syncthreads();
}

#ifndef PHASE_INLINE
#define PHASE_INLINE __forceinline__
#endif
typedef unsigned short u16;
typedef short v8s __attribute__((ext_vector_type(8)));
typedef float v4f __attribute__((ext_vector_type(4)));
typedef unsigned v4u __attribute__((ext_vector_type(4)));
typedef unsigned v2u __attribute__((ext_vector_type(2)));

constexpr int DM = 1024, NB = 4, SEQ = 4096, CTXL = 256, TPB = SEQ + CTXL, NTOK = NB * TPB, DEPTH = 4;
constexpr int INC = 3840, PBC = 2816, NCH = 68, NBLK = 272, NSC = 17, MOEROWS = 38912;
constexpr float ALPHA_F = 1.681792830507429f;
constexpr float LN_EPS_F = 1e-5f;
constexpr int NTHREADS = 512;

constexpr size_t MiB = 1u << 20;
constexpr size_t WS_CTL = 0, CTL_BYTES = 1 * MiB;
constexpr size_t WS_TAB = 1 * MiB;
constexpr size_t TAB_MOD = 0, TAB_LB = 512 * 1024, TAB_ROPE = 544 * 1024, TAB_A16 = 576 * 1024;
constexpr size_t WS_GLUW = 2 * MiB, WS_BTE = 3 * MiB, WS_BTY = 11 * MiB, WS_WIN = 27 * MiB, WS_WOUT = 35 * MiB, WS_WGU = 37 * MiB, WS_WDN = 69 * MiB;
constexpr size_t WS_X = 85 * MiB, WS_H = 153 * MiB, WS_ROUTE = 187 * MiB, WS_SCR = 188 * MiB;
constexpr size_t RT_TOKE = 0, RT_TOKW = 160 * 1024, RT_TOKP = 320 * 1024, RT_RINFO = 480 * 1024, RT_ROWW = 640 * 1024;
constexpr size_t WS_PB = 188 * MiB, WS_LF = 282 * MiB, WS_SB = 350 * MiB, WS_SA = 418 * MiB, WS_RB = 420 * MiB, WS_E = 437 * MiB, WS_HS = 454 * MiB, WS_S5G = 463 * MiB, WS_MX = 472 * MiB;
constexpr size_t WS_HSORT = 188 * MiB, WS_HID = 264 * MiB, WS_Y2 = 302 * MiB;
constexpr size_t WS_END = 506 * MiB;
static_assert(WS_PB + (size_t)NTOK * PBC * 2 <= WS_LF && WS_LF + (size_t)NTOK * 1024 * 4 <= WS_SB && WS_SB + (size_t)2176 * 16384 * 2 <= WS_SA, "ws map 1");
static_assert(WS_SA + (size_t)2176 * 128 * 4 <= WS_RB && WS_RB + (size_t)2176 * 4096 * 2 <= WS_E && WS_E + (size_t)128 * 272 * 128 * 4 <= WS_HS, "ws map 2");
static_assert(WS_HS + (size_t)128 * 272 * 128 * 2 <= WS_S5G && WS_S5G + (size_t)NTOK * 256 * 2 <= WS_MX && WS_MX + (size_t)NTOK * 1024 * 2 <= WS_END, "ws map 3");
static_assert(WS_HSORT + (size_t)MOEROWS * 1024 * 2 <= WS_HID && WS_HID + (size_t)MOEROWS * 512 * 2 <= WS_Y2 && WS_Y2 + (size_t)2 * NTOK * 1024 * 4 <= WS_MX, "ws map 4");
static_assert(WS_X + (size_t)NTOK * 1024 * 4 <= WS_H && WS_H + (size_t)NTOK * 1024 * 2 <= WS_ROUTE, "ws map 5");
static_assert(WS_WIN + (size_t)INC * 1024 * 2 <= WS_WOUT && WS_WGU + (size_t)16 * 1024 * 1024 * 2 <= WS_WDN && WS_WDN + (size_t)16 * 1024 * 512 * 2 <= WS_X, "ws map 6");
constexpr int CW_BAR = 4096, CW_CNT = 16384;

constexpr int LDS_STAGE = 131072;
constexpr int LDS_MISC = LDS_STAGE;
constexpr int LDS_BYTES = 147456;

struct Params {
    const float* in[34];
    float* out;
    unsigned char* ws;
};

typedef const __attribute__((address_space(4))) Params* KP;
__device__ __forceinline__ KP kparams() { KP k = (KP)__builtin_amdgcn_kernarg_segment_ptr(); asm volatile("" : "+s"(k)); return k; }
__device__ __forceinline__ int opaque_tid() { int t = threadIdx.x; asm volatile("" : "+v"(t)); return t; }
__device__ __forceinline__ float bf2f(u16 v) { return __uint_as_float(((unsigned)v) << 16); }
typedef __bf16 bf2_t __attribute__((ext_vector_type(2)));
typedef float fl2_t __attribute__((ext_vector_type(2)));
__device__ __forceinline__ unsigned pk2(float lo, float hi) { const fl2_t f = {lo, hi}; const bf2_t b = __builtin_convertvector(f, bf2_t); return __builtin_bit_cast(unsigned, b); }
__device__ __forceinline__ u16 f2bf(float f) { return (u16)(pk2(f, 0.f) & 0xffffu); }
__device__ __forceinline__ float sigm(float x) { return 1.f / (1.f + __expf(-x)); }
__device__ __forceinline__ float siluf(float x) { return x / (1.f + __expf(-x)); }
__device__ __forceinline__ float gelu_tanh(float x) { const float y = 0.7978845608028654f * (x + 0.044715f * x * x * x); const float t = 1.f - 2.f / (1.f + __expf(2.f * y)); return 0.5f * x * (1.f + t); }
__device__ __forceinline__ float shx(float v, int o, int lane) { return __int_as_float(__builtin_amdgcn_ds_bpermute((lane ^ o) << 2, __float_as_int(v))); }
__device__ __forceinline__ float wave_sum(float v, int lane) {
#pragma unroll
    for (int o = 32; o >= 1; o >>= 1) v += shx(v, o, lane);
    return v;
}
__device__ __forceinline__ v4f mma16(v8s a, v8s b, v4f c) { return __builtin_amdgcn_mfma_f32_16x16x32_bf16(a, b, c, 0, 0, 0); }
__device__ __forceinline__ v8s ldfrag(const u16* base, int pitch, int row0, int k0, int lane) { return *(const v8s*)(base + (size_t)(row0 + (lane & 15)) * pitch + k0 + 8 * (lane >> 4)); }
__device__ __forceinline__ float red_angle(float a) { return a - 6.283185307179586f * rintf(a * 0.15915494309189535f); }
__device__ __forceinline__ int mod_index(int row) { const int b = row / TPB; return (row - b * TPB) < CTXL ? 4 : b; }

template <class CP> __device__ __forceinline__ void conv_tile(u16* dst, int ldd, int lds_, int n0, int k0, const CP& colptr, float* tile) {
    const int tid = opaque_tid();
    { const int nn = tid & 63, kk = tid >> 6; const float* sp = colptr(n0 + nn);
#pragma unroll
      for (int r = 0; r < 8; ++r) { const int k = r * 8 + kk; tile[k * 65 + nn] = sp[(size_t)(k0 + k) * lds_]; } }
    __syncthreads();
    { const int n = tid >> 3, ks = tid & 7; float v[8];
#pragma unroll
      for (int j = 0; j < 8; ++j) v[j] = tile[(ks * 8 + j) * 65 + n];
      v4u w; w.x = pk2(v[0], v[1]); w.y = pk2(v[2], v[3]); w.z = pk2(v[4], v[5]); w.w = pk2(v[6], v[7]);
      *(v4u*)(dst + (size_t)(n0 + n) * ldd + k0 + ks * 8) = w; }
    __syncthreads();
}
struct CpPlain { const float* base; __device__ __forceinline__ const float* operator()(int n) const { return base + n; } };
struct CpWin { const float* base; __device__ __forceinline__ const float* operator()(int n) const {
    int s = n; if (n >= 2560 && n < 3072) { const int n32 = n & 31, i = n32 >> 1; s = (n & ~31) + ((n32 & 1) ? 16 + i : i); } return base + s; } };
struct CpGU { const float* gate; long diff; __device__ __forceinline__ const float* operator()(int r) const {
    const int hidden = 4 * (r >> 3) + (r & 3); return gate + (long)((r >> 2) & 1) * diff + hidden; } };

__device__ __forceinline__ void conv_win(KP p, int l, int t, float* tile) {
    const int nt = t >> 4, kt = t & 15; CpWin cp{p->in[6] + (size_t)l * 1024 * INC};
    conv_tile((u16*)(p->ws + WS_WIN), 1024, INC, nt * 64, kt * 64, cp, tile);
}
__device__ __forceinline__ void conv_wout(KP p, int l, int t, float* tile) {
    const int nt = t >> 4, kt = t & 15; CpPlain cp{p->in[22] + (size_t)l * 1024 * 1024};
    conv_tile((u16*)(p->ws + WS_WOUT), 1024, 1024, nt * 64, kt * 64, cp, tile);
}
__device__ __forceinline__ void conv_wgu(KP p, int l, int t, float* tile) {
    const int e = t >> 8, nt = (t >> 4) & 15, kt = t & 15; const size_t eo = (size_t)(l * 16 + e) * 1024 * 512;
    CpGU cp{p->in[31] + eo, (long)(p->in[32] - p->in[31])};
    conv_tile((u16*)(p->ws + WS_WGU) + (size_t)e * 1024 * 1024, 1024, 512, nt * 64, kt * 64, cp, tile);
}
__device__ __forceinline__ void conv_wdn(KP p, int l, int t, float* tile) {
    const int e = t >> 7, nt = (t >> 3) & 15, kt = t & 7; CpPlain cp{p->in[33] + (size_t)(l * 16 + e) * 512 * 1024};
    conv_tile((u16*)(p->ws + WS_WDN) + (size_t)e * 1024 * 512, 512, 1024, nt * 64, kt * 64, cp, tile);
}

__device__ PHASE_INLINE void p0_prologue(KP p, unsigned char* smem) {
    const int tid = opaque_tid(), lane = tid & 63, wave = tid >> 6, G = gridDim.x;
    float* TABf = (float*)(p->ws + WS_TAB);
    constexpr int N_MOD = 384, N_TAB = 1, N_S5 = 64, N_GLU = 64, N_WIN = 960;
    constexpr int O_TAB = N_MOD, O_S5 = O_TAB + N_TAB, O_GLU = O_S5 + N_S5, O_WIN = O_GLU + N_GLU, TOTAL = O_WIN + N_WIN;
    for (int it = blockIdx.x; it < TOTAL; it += G) {
        if (it < O_TAB) {
            float* sc = (float*)smem; float* red = sc + 5120;
            for (int i = tid; i < 5120; i += NTHREADS) { const int r = i >> 10, k = i & 1023; const float cv = r < 4 ? p->in[1][r * 1024 + k] : p->in[3][k]; sc[i] = siluf(cv); }
            __syncthreads();
            const int l = it / 96, nb = it % 96, n = nb * 64 + lane;
            const float* wp = p->in[4] + (size_t)l * 1024 * 6144 + n;
            float a0 = 0.f, a1 = 0.f, a2 = 0.f, a3 = 0.f, a4 = 0.f;
#pragma unroll 8
            for (int k = wave * 128; k < wave * 128 + 128; ++k) { const float wv = wp[(size_t)k * 6144];
                a0 += sc[k] * wv; a1 += sc[1024 + k] * wv; a2 += sc[2048 + k] * wv; a3 += sc[3072 + k] * wv; a4 += sc[4096 + k] * wv; }
            red[(wave * 5 + 0) * 64 + lane] = a0; red[(wave * 5 + 1) * 64 + lane] = a1; red[(wave * 5 + 2) * 64 + lane] = a2; red[(wave * 5 + 3) * 64 + lane] = a3; red[(wave * 5 + 4) * 64 + lane] = a4;
            __syncthreads();
            if (tid < 320) { const int r = tid >> 6, ln = tid & 63; float s = 0.f;
#pragma unroll
                for (int w = 0; w < 8; ++w) s += red[(w * 5 + r) * 64 + ln];
                const int nn = nb * 64 + ln; TABf[TAB_MOD / 4 + (size_t)(l * 5 + r) * 6144 + nn] = s + p->in[5][l * 6144 + nn]; }
            __syncthreads();
        } else if (it < O_S5) {
            for (int i = tid; i < 1024; i += NTHREADS) {
                const float r0 = p->in[7][i], r1 = p->in[7][1024 + i], r2 = p->in[7][2048 + i], r3 = p->in[7][3072 + i];
                const float m = fmaxf(fmaxf(r0, r1), fmaxf(r2, r3));
                const float e0 = expf(r0 - m), e1 = expf(r1 - m), e2 = expf(r2 - m), e3 = expf(r3 - m), inv = 1.f / (e0 + e1 + e2 + e3);
                float* LB = TABf + TAB_LB / 4;
                LB[i] = 0.f; LB[1024 + i] = e1 * inv; LB[2048 + i] = (e1 + e2) * inv; LB[3072 + i] = (e1 + e2 + e3) * inv; }
            for (int i = tid; i < 1024; i += NTHREADS) { const int pos = i >> 4, k = i & 15;
                const float inv = exp2f(-(float)k * (13.287712379549449f / 16.f)); const float ang = red_angle((float)pos * inv);
                TABf[TAB_ROPE / 4 + 2 * i] = __cosf(ang); TABf[TAB_ROPE / 4 + 2 * i + 1] = __sinf(ang); }
        } else if (it < O_GLU) {
            const int l = (it - O_S5) >> 4, g = (it - O_S5) & 15;
            float2* pw = (float2*)smem;
            float2* bbar = pw + 2 * 17 * 64;
            float2* cc = bbar + 2 * 64 * 16;
            float* Kt = (float*)(cc + 2 * 16 * 64);
            if (tid < 128) { const int d = tid >> 6, pp = tid & 63; const int pi = ((l * 2 + d) * 16 + g) * 64 + pp;
                const float lre = fminf(p->in[12][pi], -1e-4f), lim = p->in[13][pi], dt = expf(p->in[14][(l * 2 + d) * 16 + g]);
                for (int tau = 0; tau <= 16; ++tau) { const float mag = expf((float)tau * dt * lre), ang = red_angle((float)tau * dt * lim);
                    pw[(d * 17 + tau) * 64 + pp] = make_float2(mag * __cosf(ang), mag * __sinf(ang)); }
                const float2 ab = pw[(d * 17 + 1) * 64 + pp]; const float nr = ab.x - 1.f, ni = ab.y, den = lre * lre + lim * lim;
                const float cre = (nr * lre + ni * lim) / den, cim = (ni * lre - nr * lim) / den;
                ((float2*)(p->ws + WS_TAB + TAB_A16))[pi] = pw[(d * 17 + 16) * 64 + pp];
                for (int c = 0; c < 16; ++c) { const float br = p->in[15][(size_t)pi * 16 + c], bi = p->in[16][(size_t)pi * 16 + c];
                    bbar[(d * 64 + pp) * 16 + c] = make_float2(cre * br - cim * bi, cre * bi + cim * br); } }
            for (int i = tid; i < 2048; i += NTHREADS) { const int d = i >> 10, c = (i >> 6) & 15, pp = i & 63; const size_t ci = (size_t)(((l * 2 + d) * 16 + g) * 16 + c) * 64 + pp;
                cc[i] = make_float2(p->in[17][ci], p->in[18][ci]); }
            __syncthreads();
            for (int i = tid; i < 8192; i += NTHREADS) { const int d = i >> 12, tau = (i >> 8) & 15, c = (i >> 4) & 15, c2 = i & 15; float s = 0.f;
                for (int pp = 0; pp < 64; ++pp) { const float2 C = cc[(d * 16 + c) * 64 + pp], W = pw[(d * 17 + tau) * 64 + pp], Bv = bbar[(d * 64 + pp) * 16 + c2];
                    const float mx = C.x * W.x - C.y * W.y, my = C.x * W.y + C.y * W.x; s += mx * Bv.x - my * Bv.y; }
                Kt[i] = s; }
            __syncthreads();
            u16* BTY = (u16*)(p->ws + WS_BTY) + (size_t)(l * 16 + g) * 256 * 512;
            for (int pr = tid; pr < 65536; pr += NTHREADS) { const int n = pr >> 8, kk0 = (pr & 255) * 2, ti = n >> 4, c = n & 15; float v[2];
#pragma unroll
                for (int e = 0; e < 2; ++e) { const int kk = kk0 + e; float val;
                    if (kk < 256) { const int tj = kk >> 4, c2 = kk & 15; val = 0.f;
                        if (ti >= tj) val += Kt[((0 * 16 + (ti - tj)) * 16 + c) * 16 + c2];
                        if (ti <= tj) val += Kt[((1 * 16 + (tj - ti)) * 16 + c) * 16 + c2]; }
                    else { const int q = (kk - 256) >> 6, pp = kk & 63, d = q >> 1, tau = d ? 16 - ti : ti + 1;
                        const float2 C = cc[(d * 16 + c) * 64 + pp], W = pw[(d * 17 + tau) * 64 + pp];
                        val = (q & 1) ? -(C.x * W.y + C.y * W.x) : (C.x * W.x - C.y * W.y); }
                    v[e] = val; }
                *(unsigned*)(BTY + (size_t)n * 512 + kk0) = pk2(v[0], v[1]); }
            for (int pr = tid; pr < 32768; pr += NTHREADS) { const int d = pr >> 14, n = (pr >> 7) & 127, kk0 = (pr & 127) * 2, pp = n & 63, im = n >> 6; float v[2];
#pragma unroll
                for (int e = 0; e < 2; ++e) { const int kk = kk0 + e, tj = kk >> 4, c2 = kk & 15, tau = d ? tj : 15 - tj;
                    const float2 W = pw[(d * 17 + tau) * 64 + pp], Bv = bbar[(d * 64 + pp) * 16 + c2];
                    v[e] = im ? (W.x * Bv.y + W.y * Bv.x) : (W.x * Bv.x - W.y * Bv.y); }
                *(unsigned*)((u16*)(p->ws + WS_BTE) + ((size_t)((l * 2 + d) * 16 + g) * 128 + n) * 256 + kk0) = pk2(v[0], v[1]); }
            __syncthreads();
        } else if (it < O_WIN) {
            const int t = it - O_GLU, l = t >> 4, nt = (t >> 2) & 3, kt = t & 3; CpPlain cp{p->in[20] + (size_t)l * 256 * 256};
            conv_tile((u16*)(p->ws + WS_GLUW) + (size_t)l * 256 * 256, 256, 256, nt * 64, kt * 64, cp, (float*)smem);
        } else {
            conv_win(p, 0, it - O_WIN, (float*)smem);
        }
    }
}

__device__ PHASE_INLINE void p0b_init(KP p) {
    const int tid = opaque_tid(), lane = tid & 63, wave = tid >> 6, G = gridDim.x;
    const float* MOD = (const float*)(p->ws + WS_TAB + TAB_MOD);
    float* X = (float*)(p->ws + WS_X); u16* H = (u16*)(p->ws + WS_H);
    for (int r = blockIdx.x * 8 + wave; r < NTOK; r += G * 8) {
        const int b = r / TPB, t = r - b * TPB; const bool isc = t < CTXL; const int mi = isc ? 4 : b;
        const float* src = isc ? p->in[2] + (size_t)(b * CTXL + t) * DM : p->in[0] + (size_t)(b * SEQ + (t - CTXL)) * DM;
        const float* md = MOD + (size_t)(0 * 5 + mi) * 6144;
#pragma unroll
        for (int j = 0; j < 4; ++j) { const int col = 4 * lane + 256 * j; const v4f v = *(const v4f*)(src + col);
            *(v4f*)(X + (size_t)r * DM + col) = v;
            const v4f sh = *(const v4f*)(md + col), s1 = *(const v4f*)(md + 1024 + col); const v4f h = v * (1.f + s1) + sh;
            v2u w; w.x = pk2(h[0], h[1]); w.y = pk2(h[2], h[3]); *(v2u*)(H + (size_t)r * DM + col) = w; }
    }
}
typedef pg8::f32x4 A4;
struct EpiIn {
    static constexpr bool PERM = true, AFTER_DRAIN = false;
    u16* Pb; float* LF; const float* lb; const float* rope;
    __device__ __forceinline__ void operator()(const A4 (&acc)[2][2][4][2], const pg8::Unit& u, int wr, int wc, int fr, int fq) const {
        const int pn = u.pn;
#pragma unroll
        for (int ai = 0; ai < 2; ++ai)
#pragma unroll
            for (int m = 0; m < 4; ++m) {
                asm volatile("" ::: "memory");
                const int row = u.pm * 256 + ai * 128 + wr * 64 + m * 16 + fr;
#pragma unroll
                for (int bj = 0; bj < 2; ++bj) {
                    A4 v0 = acc[ai][bj][m][0], v1 = acc[ai][bj][m][1];
                    const int col = pn * 256 + bj * 128 + wc * 32 + fq * 8;
                    if (pn >= 6 && pn <= 9) {
                        const int d = (pn - 6) >> 1, hc = col - 1536 - 512 * d;
                        const A4 l0 = *(const A4*)(lb + d * 512 + hc), l1 = *(const A4*)(lb + d * 512 + hc + 4);
                        A4 o0, o1;
#pragma unroll
                        for (int e = 0; e < 4; ++e) { o0[e] = __logf(l0[e] + (1.f - l0[e]) * sigm(v0[e])); o1[e] = __logf(l1[e] + (1.f - l1[e]) * sigm(v1[e])); }
                        float* dst = LF + (size_t)row * 1024 + d * 512 + hc; *(A4*)dst = o0; *(A4*)(dst + 4) = o1;
                    } else {
                        int pc = col < 1536 ? col : col - 1024;
                        if (pn == 0 || pn == 1 || pn == 4 || pn == 5 || pn == 13) {
#pragma unroll
                            for (int e = 0; e < 4; ++e) { v0[e] = siluf(v0[e]); v1[e] = siluf(v1[e]); }
                        } else if (pn == 10 || pn == 11) {
                            const float sc = pn == 11 ? 0.125f : 1.f;
                            const int b = row / TPB, t = row - b * TPB;
                            if (t >= CTXL) {
                                const int tl = t - CTXL, pos = (wc & 1) ? (tl & 63) : (tl >> 6);
                                const A4 cs0 = *(const A4*)(rope + (pos * 16 + 4 * fq) * 2), cs1 = *(const A4*)(rope + (pos * 16 + 4 * fq + 2) * 2);
                                A4 r0, r1;
                                r0[0] = v0[0] * cs0[0] - v0[1] * cs0[1]; r0[1] = v0[0] * cs0[1] + v0[1] * cs0[0];
                                r0[2] = v0[2] * cs0[2] - v0[3] * cs0[3]; r0[3] = v0[2] * cs0[3] + v0[3] * cs0[2];
                                r1[0] = v1[0] * cs1[0] - v1[1] * cs1[1]; r1[1] = v1[0] * cs1[1] + v1[1] * cs1[0];
                                r1[2] = v1[2] * cs1[2] - v1[3] * cs1[3]; r1[3] = v1[2] * cs1[3] + v1[3] * cs1[2];
                                v0 = r0; v1 = r1;
                            }
                            v0 = v0 * sc; v1 = v1 * sc;
                        }
                        pg8::u32x4 w; w.x = pg8::cvt_pk_bf16(v0[0], v0[1]); w.y = pg8::cvt_pk_bf16(v0[2], v0[3]); w.z = pg8::cvt_pk_bf16(v1[0], v1[1]); w.w = pg8::cvt_pk_bf16(v1[2], v1[3]);
                        *(pg8::u32x4*)(Pb + (size_t)row * PBC + pc) = w;
                    }
                }
            }
    }
};
struct EpiGlu {
    static constexpr bool PERM = true, AFTER_DRAIN = false;
    const u16* S5G; u16* Mx; const float* bias;
    __device__ __forceinline__ void operator()(const A4 (&acc)[2][2][4][2], const pg8::Unit& u, int wr, int wc, int fr, int fq) const {
#pragma unroll
        for (int ai = 0; ai < 2; ++ai)
#pragma unroll
            for (int m = 0; m < 4; ++m) {
                asm volatile("" ::: "memory");
                const int row = u.pm * 256 + ai * 128 + wr * 64 + m * 16 + fr;
#pragma unroll
                for (int bj = 0; bj < 2; ++bj) {
                    const int col = bj * 128 + wc * 32 + fq * 8;
                    const A4 b0 = *(const A4*)(bias + col), b1 = *(const A4*)(bias + col + 4);
                    const A4 v0 = acc[ai][bj][m][0] + b0, v1 = acc[ai][bj][m][1] + b1;
                    const pg8::u32x4 sv = *(const pg8::u32x4*)(S5G + (size_t)row * 256 + col);
                    float s[8]; s[0] = __uint_as_float(sv.x << 16); s[1] = __uint_as_float(sv.x & 0xffff0000u); s[2] = __uint_as_float(sv.y << 16); s[3] = __uint_as_float(sv.y & 0xffff0000u);
                    s[4] = __uint_as_float(sv.z << 16); s[5] = __uint_as_float(sv.z & 0xffff0000u); s[6] = __uint_as_float(sv.w << 16); s[7] = __uint_as_float(sv.w & 0xffff0000u);
                    pg8::u32x4 w; w.x = pg8::cvt_pk_bf16(s[0] * sigm(v0[0]), s[1] * sigm(v0[1])); w.y = pg8::cvt_pk_bf16(s[2] * sigm(v0[2]), s[3] * sigm(v0[3]));
                    w.z = pg8::cvt_pk_bf16(s[4] * sigm(v1[0]), s[5] * sigm(v1[1])); w.w = pg8::cvt_pk_bf16(s[6] * sigm(v1[2]), s[7] * sigm(v1[3]));
                    *(pg8::u32x4*)(Mx + (size_t)row * 1024 + 768 + col) = w;
                }
            }
    }
};
struct EpiOut {
    static constexpr bool PERM = true, AFTER_DRAIN = false;
    float* X; const float* mod;
    __device__ __forceinline__ void operator()(const A4 (&acc)[2][2][4][2], const pg8::Unit& u, int wr, int wc, int fr, int fq) const {
        const int b = u.pm / 17, mi = (u.pm - b * 17) == 0 ? 4 : b; const float* gp = mod + (size_t)mi * 6144 + 2048;
#pragma unroll
        for (int ai = 0; ai < 2; ++ai)
#pragma unroll
            for (int m = 0; m < 4; ++m) {
                asm volatile("" ::: "memory");
                const int row = u.pm * 256 + ai * 128 + wr * 64 + m * 16 + fr;
#pragma unroll
                for (int bj = 0; bj < 2; ++bj) {
                    const int col = u.pn * 256 + bj * 128 + wc * 32 + fq * 8; float* xp = X + (size_t)row * DM + col;
                    const A4 g0 = *(const A4*)(gp + col), g1 = *(const A4*)(gp + col + 4);
                    const A4 x0 = *(const A4*)xp, x1 = *(const A4*)(xp + 4);
                    *(A4*)xp = x0 * ALPHA_F + g0 * acc[ai][bj][m][0]; *(A4*)(xp + 4) = x1 * ALPHA_F + g1 * acc[ai][bj][m][1];
                }
            }
    }
};
struct EpiGU {
    static constexpr bool PERM = true, AFTER_DRAIN = false;
    u16* Hid;
    __device__ __forceinline__ void operator()(const A4 (&acc)[2][2][4][2], const pg8::Unit& u, int wr, int wc, int fr, int fq) const {
#pragma unroll
        for (int ai = 0; ai < 2; ++ai)
#pragma unroll
            for (int m = 0; m < 4; ++m) {
                asm volatile("" ::: "memory");
                const int row = u.pm * 256 + ai * 128 + wr * 64 + m * 16 + fr;
#pragma unroll
                for (int bj = 0; bj < 2; ++bj) {
                    const int hc = (u.pn & 3) * 128 + bj * 64 + wc * 16 + fq * 4;
                    const A4 a = acc[ai][bj][m][0], bb = acc[ai][bj][m][1];
                    v2u w; w.x = pg8::cvt_pk_bf16(siluf(a[0]) * bb[0], siluf(a[1]) * bb[1]); w.y = pg8::cvt_pk_bf16(siluf(a[2]) * bb[2], siluf(a[3]) * bb[3]);
                    *(v2u*)(Hid + (size_t)row * 512 + hc) = w;
                }
            }
    }
};
struct EpiDown {
    static constexpr bool PERM = true, AFTER_DRAIN = false;
    float* Y2; const int* rinfo; const float* roww;
    __device__ __forceinline__ void operator()(const A4 (&acc)[2][2][4][2], const pg8::Unit& u, int wr, int wc, int fr, int fq) const {
#pragma unroll
        for (int ai = 0; ai < 2; ++ai)
#pragma unroll
            for (int m = 0; m < 4; ++m) {
                asm volatile("" ::: "memory");
                const int prow = u.pm * 256 + ai * 128 + wr * 64 + m * 16 + fr;
                const int info = rinfo[prow];
                if (info >= 0) {
                    const float w = roww[prow]; float* dst = Y2 + ((size_t)(info & 1) * NTOK + (info >> 1)) * DM;
#pragma unroll
                    for (int bj = 0; bj < 2; ++bj) { const int col = (u.pn & 3) * 256 + bj * 128 + wc * 32 + fq * 8;
                        *(A4*)(dst + col) = acc[ai][bj][m][0] * w; *(A4*)(dst + col + 4) = acc[ai][bj][m][1] * w; }
                }
            }
    }
};
struct MoeOrder {
    const int* tileE; int nT, G, c;
    __device__ __forceinline__ bool next(int i, pg8::Unit& u) const { const int L = i * G + c; if (L >= nT * 4) return false; u.pm = L >> 2; u.pn = tileE[L >> 2] * 4 + (L & 3); return true; }
    __device__ __forceinline__ void a_ready(const pg8::Unit&) const {}
    __device__ __forceinline__ void done(const pg8::Unit&) const {}
};
__device__ PHASE_INLINE void sc1_phase(KP p, int l, unsigned char* smem) {
    const int G = gridDim.x;
    const u16* Pb = (const u16*)(p->ws + WS_PB); const float* LF = (const float*)(p->ws + WS_LF);
    u16* SB = (u16*)(p->ws + WS_SB); float* SA = (float*)(p->ws + WS_SA); u16* RB = (u16*)(p->ws + WS_RB); float* E = (float*)(p->ws + WS_E);
    constexpr int N_HG = 1088, N_RT = 272, N_S5 = 1088;
    { const int tid = opaque_tid(), lane = tid & 63, wave = tid >> 6, q4 = lane >> 4, r16 = lane & 15;
      for (int it = blockIdx.x; it < N_HG; it += G) {
            const int b = it / 272, c = (it % 272) >> 2, h = it & 3, R0 = b * TPB + c * 64;
            u16* ktT = (u16*)smem;
            u16* vT = ktT + 2 * 128 * 72;
            if (tid < 256) { const int d = tid >> 7, ch = tid & 127; float r = 0.f;
                const float* lf = LF + (size_t)R0 * 1024 + d * 512 + h * 128 + ch;
#pragma unroll 1
                for (int pb = 48; pb >= 0; pb -= 16) { float v[16];
#pragma unroll
                    for (int j = 0; j < 16; ++j) { const int pp = pb + j, tok = d ? 63 - pp : pp; v[j] = lf[(size_t)tok * 1024]; }
#pragma unroll
                    for (int j = 15; j >= 0; --j) { const int pp = pb + j, tok = d ? 63 - pp : pp; const float kt = (1.f - __expf(v[j])) * __expf(r);
                        ktT[(d * 128 + ch) * 72 + tok] = f2bf(kt); r += v[j]; } }
                SA[((size_t)((b * 4 + h) * 2 + d) * NCH + c) * 128 + ch] = __expf(r); }
#pragma unroll
            for (int i = 0; i < 2; ++i) { const int idx = tid + 512 * i, tok = idx >> 4, seg = idx & 15;
                const pg8::u32x4 w = *(const pg8::u32x4*)(Pb + (size_t)(R0 + tok) * PBC + 512 + h * 128 + seg * 8);
                u16* d0 = vT + (seg * 8) * 72 + tok;
                d0[0 * 72] = (u16)(w.x & 0xffff); d0[1 * 72] = (u16)(w.x >> 16); d0[2 * 72] = (u16)(w.y & 0xffff); d0[3 * 72] = (u16)(w.y >> 16);
                d0[4 * 72] = (u16)(w.z & 0xffff); d0[5 * 72] = (u16)(w.z >> 16); d0[6 * 72] = (u16)(w.w & 0xffff); d0[7 * 72] = (u16)(w.w >> 16); }
            __syncthreads();
#pragma unroll 2
            for (int i = 0; i < 16; ++i) { const int tt = wave + 8 * i, d = tt >> 6, mt = (tt >> 3) & 7, nt = tt & 7;
                v4f acc = {0.f, 0.f, 0.f, 0.f};
#pragma unroll
                for (int ks = 0; ks < 2; ++ks) acc = mma16(ldfrag(ktT + d * 128 * 72, 72, 16 * mt, 32 * ks, lane), ldfrag(vT, 72, 16 * nt, 32 * ks, lane), acc);
                v2u w; w.x = pk2(acc[0], acc[1]); w.y = pk2(acc[2], acc[3]);
                *(v2u*)(SB + ((size_t)((b * 4 + h) * 2 + d) * NCH + c) * 16384 + (16 * nt + r16) * 128 + 16 * mt + 4 * q4) = w; }
            __syncthreads();
      } }
    { const int tid = opaque_tid(), lane = tid & 63, wave = tid >> 6, q4 = lane >> 4, r16 = lane & 15;
      for (int it = (blockIdx.x + G - 64 % G) % G; it < N_RT; it += G) {
            const int t2 = it, b = t2 / NCH, c = t2 % NCH, R0 = b * TPB + c * 64;
            u16* ktT = (u16*)smem;
            u16* vT = ktT + 2 * 64 * 72;
            for (int h = 0; h < 4; ++h) {
                const float rf = p->in[9][l * 8 + h], rb = p->in[9][l * 8 + 4 + h];
                const float lgf = -__logf(1.f + __expf(-rf)), lgb = -__logf(1.f + __expf(-rb));
                { const int tok = tid >> 3, seg = tid & 7;
                  const pg8::u32x4 kw = *(const pg8::u32x4*)(Pb + (size_t)(R0 + tok) * PBC + 1792 + h * 64 + seg * 8);
                  const pg8::u32x4 vw = *(const pg8::u32x4*)(Pb + (size_t)(R0 + tok) * PBC + 2048 + h * 64 + seg * 8);
                  const float df = __expf(lgf * (float)(63 - tok)), db = __expf(lgb * (float)tok);
                  const unsigned kk[4] = {kw.x, kw.y, kw.z, kw.w}, vv[4] = {vw.x, vw.y, vw.z, vw.w};
#pragma unroll
                  for (int j = 0; j < 4; ++j) { const float k0 = __uint_as_float(kk[j] << 16), k1 = __uint_as_float(kk[j] & 0xffff0000u); const int ch = seg * 8 + 2 * j;
                      ktT[(ch) * 72 + tok] = f2bf(k0 * df); ktT[(ch + 1) * 72 + tok] = f2bf(k1 * df);
                      ktT[(64 + ch) * 72 + tok] = f2bf(k0 * db); ktT[(64 + ch + 1) * 72 + tok] = f2bf(k1 * db);
                      vT[(ch) * 72 + tok] = (u16)(vv[j] & 0xffff); vT[(ch + 1) * 72 + tok] = (u16)(vv[j] >> 16); } }
                __syncthreads();
#pragma unroll
                for (int i = 0; i < 4; ++i) { const int tt = wave + 8 * i, d = tt >> 4, mt = (tt >> 2) & 3, nt = tt & 3;
                    v4f acc = {0.f, 0.f, 0.f, 0.f};
#pragma unroll
                    for (int ks = 0; ks < 2; ++ks) acc = mma16(ldfrag(ktT + d * 64 * 72, 72, 16 * mt, 32 * ks, lane), ldfrag(vT, 72, 16 * nt, 32 * ks, lane), acc);
                    v2u w; w.x = pk2(acc[0], acc[1]); w.y = pk2(acc[2], acc[3]);
                    *(v2u*)(RB + ((size_t)((b * 4 + h) * 2 + d) * NCH + c) * 4096 + (16 * nt + r16) * 64 + 16 * mt + 4 * q4) = w; }
                __syncthreads();
            }
      } }
    { const int tid = opaque_tid(), lane = tid & 63, wave = tid >> 6, q4 = lane >> 4, r16 = lane & 15; (void)tid;
      for (int it = (blockIdx.x + G - 80 % G) % G; it < N_S5; it += G) {
            const int t2 = it, b = t2 / 272, sc = (t2 % 272) >> 4, g = t2 & 15, R0 = b * TPB + sc * 256;
            v8s a[8];
#pragma unroll
            for (int ks = 0; ks < 8; ++ks) a[ks] = *(const v8s*)(Pb + (size_t)(R0 + r16 * 16 + 2 * ks + (q4 >> 1)) * PBC + 2560 + g * 16 + 8 * (q4 & 1));
#pragma unroll
            for (int d = 0; d < 2; ++d) { v4f acc = {0.f, 0.f, 0.f, 0.f};
                const u16* bt = (const u16*)(p->ws + WS_BTE) + ((size_t)((l * 2 + d) * 16 + g) * 128 + 16 * wave + r16) * 256 + 8 * q4;
#pragma unroll
                for (int ks = 0; ks < 8; ++ks) acc = mma16(a[ks], *(const v8s*)(bt + 32 * ks), acc);
                float* ep = E + ((size_t)((b * 16 + g) * 2 + d) * NBLK + sc * 16 + 4 * q4) * 128 + 16 * wave + r16;
#pragma unroll
                for (int e = 0; e < 4; ++e) ep[(size_t)e * 128] = acc[e]; }
      } }
}

__device__ PHASE_INLINE void sc2_phase(KP p, int l, unsigned char* smem) {
    const int tid = opaque_tid(), G = gridDim.x;
    u16* SB = (u16*)(p->ws + WS_SB); const float* SA = (const float*)(p->ws + WS_SA); u16* RB = (u16*)(p->ws + WS_RB); const float* E = (const float*)(p->ws + WS_E); u16* HS = (u16*)(p->ws + WS_HS);
    const int n_win = (l < DEPTH - 1) ? 960 : 0;
    constexpr int N_S5 = 128, N_HG = 256, N_RT = 64, O_HG = N_S5, O_RT = O_HG + N_HG, O_CV = O_RT + N_RT;
    const int o_wgu = O_CV + 256, o_wdn = o_wgu + 4096, o_win = o_wdn + 2048, total = o_win + n_win;
    for (int it = blockIdx.x; it < total; it += G) {
        if (it < O_HG) {
            if (tid < 64) { const int b = it >> 5, g = (it >> 1) & 15, d = it & 1, pp = tid;
                const float2 a16 = ((const float2*)(p->ws + WS_TAB + TAB_A16))[((l * 2 + d) * 16 + g) * 64 + pp];
                const float* eb = E + (size_t)((b * 16 + g) * 2 + d) * NBLK * 128; u16* hb = HS + (size_t)((b * 16 + g) * 2 + d) * NBLK * 128;
                float hr = 0.f, hi = 0.f;
                for (int s0 = 0; s0 < NBLK; s0 += 8) { float er[8], ei[8];
#pragma unroll
                    for (int j = 0; j < 8; ++j) { const int s = s0 + j, blk = d ? (s < 16 ? 15 - s : 287 - s) : s; er[j] = eb[(size_t)blk * 128 + pp]; ei[j] = eb[(size_t)blk * 128 + 64 + pp]; }
#pragma unroll
                    for (int j = 0; j < 8; ++j) { const int s = s0 + j, blk = d ? (s < 16 ? 15 - s : 287 - s) : s;
                        hb[(size_t)blk * 128 + pp] = f2bf(hr); hb[(size_t)blk * 128 + 64 + pp] = f2bf(hi);
                        const float nr = a16.x * hr - a16.y * hi + er[j], ni = a16.x * hi + a16.y * hr + ei[j]; hr = nr; hi = ni; } } }
        } else if (it < O_RT) {
            const int gid = (it - O_HG) * 512 + tid, chain = gid >> 12, e4 = (gid & 4095) * 4, dk = e4 & 127, d = chain & 1;
            u16* sb = SB + (size_t)chain * NCH * 16384 + e4; const float* sa = SA + (size_t)chain * NCH * 128 + dk;
            float S0 = 0.f, S1 = 0.f, S2 = 0.f, S3 = 0.f;
            for (int s0 = 0; s0 < NCH; s0 += 4) { v2u bv[4]; v4f av[4];
#pragma unroll
                for (int j = 0; j < 4; ++j) { const int s = s0 + j, c = d ? (s < 4 ? 3 - s : 71 - s) : s; bv[j] = *(const v2u*)(sb + (size_t)c * 16384); av[j] = *(const v4f*)(sa + (size_t)c * 128); }
#pragma unroll
                for (int j = 0; j < 4; ++j) { const int s = s0 + j, c = d ? (s < 4 ? 3 - s : 71 - s) : s;
                    v2u w; w.x = pk2(S0, S1); w.y = pk2(S2, S3); *(v2u*)(sb + (size_t)c * 16384) = w;
                    S0 = av[j][0] * S0 + __uint_as_float(bv[j].x << 16); S1 = av[j][1] * S1 + __uint_as_float(bv[j].x & 0xffff0000u);
                    S2 = av[j][2] * S2 + __uint_as_float(bv[j].y << 16); S3 = av[j][3] * S3 + __uint_as_float(bv[j].y & 0xffff0000u); } }
        } else if (it < O_CV) {
            const int gid = (it - O_RT) * 512 + tid, chain = gid >> 10, e4 = (gid & 1023) * 4, d = chain & 1, h = (chain >> 1) & 3;
            const float raw = p->in[9][l * 8 + d * 4 + h]; const float a = __expf(-64.f * __logf(1.f + __expf(-raw)));
            u16* rb = RB + (size_t)chain * NCH * 4096 + e4;
            float S0 = 0.f, S1 = 0.f, S2 = 0.f, S3 = 0.f;
            for (int s0 = 0; s0 < NCH; s0 += 4) { v2u bv[4];
#pragma unroll
                for (int j = 0; j < 4; ++j) { const int s = s0 + j, c = d ? (s < 4 ? 3 - s : 71 - s) : s; bv[j] = *(const v2u*)(rb + (size_t)c * 4096); }
#pragma unroll
                for (int j = 0; j < 4; ++j) { const int s = s0 + j, c = d ? (s < 4 ? 3 - s : 71 - s) : s;
                    v2u w; w.x = pk2(S0, S1); w.y = pk2(S2, S3); *(v2u*)(rb + (size_t)c * 4096) = w;
                    S0 = a * S0 + __uint_as_float(bv[j].x << 16); S1 = a * S1 + __uint_as_float(bv[j].x & 0xffff0000u);
                    S2 = a * S2 + __uint_as_float(bv[j].y << 16); S3 = a * S3 + __uint_as_float(bv[j].y & 0xffff0000u); } }
        } else if (it < o_wgu) { conv_wout(p, l, it - O_CV, (float*)smem);
        } else if (it < o_wdn) { conv_wgu(p, l, it - o_wgu, (float*)smem);
        } else if (it < o_win) { conv_wdn(p, l, it - o_wdn, (float*)smem);
        } else { conv_win(p, l + 1, it - o_win, (float*)smem); }
    }
}
__device__ PHASE_INLINE void sc3_phase(KP p, int l, unsigned char* smem) {
    const int G = gridDim.x;
    const u16* Pb = (const u16*)(p->ws + WS_PB); const float* LF = (const float*)(p->ws + WS_LF);
    const u16* SB = (const u16*)(p->ws + WS_SB); const u16* RB = (const u16*)(p->ws + WS_RB); const u16* HS = (const u16*)(p->ws + WS_HS);
    u16* Mx = (u16*)(p->ws + WS_MX); u16* S5G = (u16*)(p->ws + WS_S5G);
    constexpr int N_HG = 1088, N_RT = 272, N_S5 = 1088;
    { const int tid = opaque_tid(), lane = tid & 63, wave = tid >> 6, q4 = lane >> 4, r16 = lane & 15;
      for (int it = blockIdx.x; it < N_HG; it += G) {
            const int b = it / 272, c = (it % 272) >> 2, h = it & 3, R0 = b * TPB + c * 64, chain0 = (b * 4 + h) * 2;
            u16* qs = (u16*)smem;
            u16* vT = qs + 64 * 136;
            float* cum = (float*)(smem + 35840);
            u16* qt = (u16*)(smem + 68608);
            u16* qJ = (u16*)(smem + 86016);
            u16* kb = (u16*)(smem + 103424);
            u16* Pm = (u16*)(smem + 120832);
#pragma unroll
            for (int i = 0; i < 2; ++i) { const int idx = tid + 512 * i, tok = idx >> 4, seg = idx & 15;
                *(pg8::u32x4*)(qs + tok * 136 + seg * 8) = *(const pg8::u32x4*)(Pb + (size_t)(R0 + tok) * PBC + h * 128 + seg * 8);
                const pg8::u32x4 w = *(const pg8::u32x4*)(Pb + (size_t)(R0 + tok) * PBC + 512 + h * 128 + seg * 8);
                u16* d0 = vT + (seg * 8) * 72 + tok;
                d0[0 * 72] = (u16)(w.x & 0xffff); d0[1 * 72] = (u16)(w.x >> 16); d0[2 * 72] = (u16)(w.y & 0xffff); d0[3 * 72] = (u16)(w.y >> 16);
                d0[4 * 72] = (u16)(w.z & 0xffff); d0[5 * 72] = (u16)(w.z >> 16); d0[6 * 72] = (u16)(w.w & 0xffff); d0[7 * 72] = (u16)(w.w >> 16); }
            __syncthreads();
            v4f acc[4];
#pragma unroll
            for (int mt = 0; mt < 4; ++mt) acc[mt] = (v4f){0.f, 0.f, 0.f, 0.f};
            for (int d = 0; d < 2; ++d) {
                const float* lfb = LF + (size_t)R0 * 1024 + d * 512 + h * 128;
                if (tid < 128) { float r = 0.f; const float* lf = lfb + tid;
#pragma unroll 1
                    for (int pb = 0; pb < 64; pb += 16) { float v[16];
#pragma unroll
                        for (int j = 0; j < 16; ++j) { const int pp = pb + j, tok = d ? 63 - pp : pp; v[j] = lf[(size_t)tok * 1024]; }
#pragma unroll
                        for (int j = 0; j < 16; ++j) { const int pp = pb + j, tok = d ? 63 - pp : pp; r += v[j]; cum[tok * 128 + tid] = r; } } }
                __syncthreads();
#pragma unroll 2
                for (int i = tid; i < 4096; i += NTHREADS) { const int tok = i >> 6, ch = (i & 63) * 2, TB = tok >> 4;
                    const float c0 = cum[tok * 128 + ch], c1 = cum[tok * 128 + ch + 1];
                    const unsigned qw = *(const unsigned*)(qs + tok * 136 + ch); const float q0 = __uint_as_float(qw << 16), q1 = __uint_as_float(qw & 0xffff0000u);
                    *(unsigned*)(qt + tok * 136 + ch) = pk2(q0 * __expf(c0), q1 * __expf(c1));
                    const float2 lfv = *(const float2*)(lfb + (size_t)tok * 1024 + ch);
                    const int refrow = d ? (TB < 3 ? 16 * TB + 16 : -1) : (TB > 0 ? 16 * TB - 1 : -1);
                    const float j0 = refrow >= 0 ? cum[refrow * 128 + ch] : 0.f, j1 = refrow >= 0 ? cum[refrow * 128 + ch + 1] : 0.f;
                    *(unsigned*)(kb + tok * 136 + ch) = pk2((1.f - __expf(lfv.x)) * __expf(fminf(j0 - c0, 60.f)), (1.f - __expf(lfv.y)) * __expf(fminf(j1 - c1, 60.f))); }
                __syncthreads();
                { const u16* sbp = SB + ((size_t)(chain0 + d) * NCH + c) * 16384 + (16 * wave + r16) * 128 + 8 * q4; v8s bfr[4];
#pragma unroll
                  for (int ks = 0; ks < 4; ++ks) bfr[ks] = *(const v8s*)(sbp + 32 * ks);
#pragma unroll
                  for (int mt = 0; mt < 4; ++mt)
#pragma unroll
                      for (int ks = 0; ks < 4; ++ks) acc[mt] = mma16(ldfrag(qt, 136, 16 * mt, 32 * ks, lane), bfr[ks], acc[mt]); }
                for (int TB = 0; TB < 4; ++TB) {
                    const int refrow = d ? (TB < 3 ? 16 * TB + 16 : -1) : (TB > 0 ? 16 * TB - 1 : -1);
#pragma unroll 2
                    for (int i = tid; i < 4096; i += NTHREADS) { const int tok = i >> 6, ch = (i & 63) * 2;
                        const bool valid = d ? (tok <= 16 * TB + 15) : (tok >= 16 * TB);
                        const float j0 = refrow >= 0 ? cum[refrow * 128 + ch] : 0.f, j1 = refrow >= 0 ? cum[refrow * 128 + ch + 1] : 0.f;
                        const float c0 = cum[tok * 128 + ch], c1 = cum[tok * 128 + ch + 1];
                        const unsigned qw = *(const unsigned*)(qs + tok * 136 + ch); const float q0 = __uint_as_float(qw << 16), q1 = __uint_as_float(qw & 0xffff0000u);
                        const float a0 = valid ? q0 * __expf(fminf(c0 - j0, 0.f)) : 0.f, a1 = valid ? q1 * __expf(fminf(c1 - j1, 0.f)) : 0.f;
                        *(unsigned*)(qJ + tok * 136 + ch) = pk2(a0, a1); }
                    __syncthreads();
                    if (wave < 4) { const int mt = wave; v4f pa = {0.f, 0.f, 0.f, 0.f};
                        const bool nz = d ? (mt <= TB) : (mt >= TB);
                        if (nz) {
#pragma unroll
                            for (int ks = 0; ks < 4; ++ks) pa = mma16(ldfrag(qJ, 136, 16 * mt, 32 * ks, lane), ldfrag(kb, 136, 16 * TB, 32 * ks, lane), pa); }
#pragma unroll
                        for (int e = 0; e < 4; ++e) { const int ti = 16 * mt + 4 * q4 + e, tj = 16 * TB + r16; const bool keep = d ? (tj >= ti) : (tj <= ti);
                            Pm[ti * 72 + tj] = f2bf(keep ? pa[e] : 0.f); } }
                    __syncthreads();
                }
#pragma unroll
                for (int mt = 0; mt < 4; ++mt)
#pragma unroll
                    for (int ks = 0; ks < 2; ++ks) acc[mt] = mma16(ldfrag(Pm, 72, 16 * mt, 32 * ks, lane), ldfrag(vT, 72, 16 * wave, 32 * ks, lane), acc[mt]);
                __syncthreads();
            }
            float* ssq = cum;
#pragma unroll
            for (int mt = 0; mt < 4; ++mt)
#pragma unroll
                for (int e = 0; e < 4; ++e) { float s = acc[mt][e] * acc[mt][e]; s += shx(s, 1, lane); s += shx(s, 2, lane); s += shx(s, 4, lane); s += shx(s, 8, lane);
                    if (r16 == 0) ssq[wave * 64 + 16 * mt + 4 * q4 + e] = s; }
            __syncthreads();
            { const int vc = 16 * wave + r16; const float gn = p->in[8][l * 128 + vc];
#pragma unroll
              for (int mt = 0; mt < 4; ++mt)
#pragma unroll
                  for (int e = 0; e < 4; ++e) { const int tok = 16 * mt + 4 * q4 + e; float tot = 0.f;
#pragma unroll
                      for (int w = 0; w < 8; ++w) tot += ssq[w * 64 + tok];
                      const float rinv = rsqrtf(tot * (1.f / 128.f) + LN_EPS_F);
                      const float sg = bf2f(Pb[(size_t)(R0 + tok) * PBC + 1024 + h * 128 + vc]);
                      Mx[(size_t)(R0 + tok) * 1024 + h * 128 + vc] = f2bf(acc[mt][e] * rinv * gn * sg); } }
            __syncthreads();
      } }
    { const int tid = opaque_tid(), lane = tid & 63, wave = tid >> 6, q4 = lane >> 4, r16 = lane & 15;
      for (int it = (blockIdx.x + G - 64 % G) % G; it < N_RT; it += G) {
            const int t2 = it, b = t2 / NCH, c = t2 % NCH, R0 = b * TPB + c * 64;
            u16* qs = (u16*)smem;
            u16* ks_ = qs + 64 * 72;
            u16* vT = ks_ + 64 * 72;
            u16* qd = vT + 64 * 72;
            u16* Pm = qd + 64 * 136;
            float* red = (float*)(Pm + 64 * 72);
            for (int h = 0; h < 4; ++h) {
                const float rf = p->in[9][l * 8 + h], rb = p->in[9][l * 8 + 4 + h];
                const float lgf = -__logf(1.f + __expf(-rf)), lgb = -__logf(1.f + __expf(-rb));
                const int chain0 = (b * 4 + h) * 2;
                { const int tok = tid >> 3, seg = tid & 7;
                  const pg8::u32x4 qw = *(const pg8::u32x4*)(Pb + (size_t)(R0 + tok) * PBC + 1536 + h * 64 + seg * 8);
                  const pg8::u32x4 kw = *(const pg8::u32x4*)(Pb + (size_t)(R0 + tok) * PBC + 1792 + h * 64 + seg * 8);
                  const pg8::u32x4 vw = *(const pg8::u32x4*)(Pb + (size_t)(R0 + tok) * PBC + 2048 + h * 64 + seg * 8);
                  *(pg8::u32x4*)(qs + tok * 72 + seg * 8) = qw; *(pg8::u32x4*)(ks_ + tok * 72 + seg * 8) = kw;
                  const float df = __expf(lgf * (float)(tok + 1)), db = __expf(lgb * (float)(64 - tok));
                  const unsigned qq[4] = {qw.x, qw.y, qw.z, qw.w}, vv[4] = {vw.x, vw.y, vw.z, vw.w};
#pragma unroll
                  for (int j = 0; j < 4; ++j) { const float q0 = __uint_as_float(qq[j] << 16), q1 = __uint_as_float(qq[j] & 0xffff0000u); const int ch = seg * 8 + 2 * j;
                      *(unsigned*)(qd + tok * 136 + ch) = pk2(q0 * df, q1 * df); *(unsigned*)(qd + tok * 136 + 64 + ch) = pk2(q0 * db, q1 * db);
                      vT[(ch) * 72 + tok] = (u16)(vv[j] & 0xffff); vT[(ch + 1) * 72 + tok] = (u16)(vv[j] >> 16); } }
                __syncthreads();
#pragma unroll
                for (int i = 0; i < 2; ++i) { const int tt = 2 * wave + i, mt = tt >> 2, nt = tt & 3; v4f pa = {0.f, 0.f, 0.f, 0.f};
#pragma unroll
                    for (int ks = 0; ks < 2; ++ks) pa = mma16(ldfrag(qs, 72, 16 * mt, 32 * ks, lane), ldfrag(ks_, 72, 16 * nt, 32 * ks, lane), pa);
#pragma unroll
                    for (int e = 0; e < 4; ++e) { const int ti = 16 * mt + 4 * q4 + e, tj = 16 * nt + r16;
                        const float D = (tj <= ti ? __expf(lgf * (float)(ti - tj)) : 0.f) + (tj >= ti ? __expf(lgb * (float)(tj - ti)) : 0.f);
                        Pm[ti * 72 + tj] = f2bf(pa[e] * D); } }
                __syncthreads();
                const int nt = wave & 3; v4f acc[2]; v8s bi[4];
#pragma unroll
                for (int d = 0; d < 2; ++d) { const u16* rbp = RB + ((size_t)(chain0 + d) * NCH + c) * 4096 + (16 * nt + r16) * 64 + 8 * q4;
                    bi[d * 2 + 0] = *(const v8s*)(rbp); bi[d * 2 + 1] = *(const v8s*)(rbp + 32); }
#pragma unroll
                for (int i = 0; i < 2; ++i) { const int mt = 2 * (wave >> 2) + i; v4f a = {0.f, 0.f, 0.f, 0.f};
#pragma unroll
                    for (int kk = 0; kk < 4; ++kk) a = mma16(ldfrag(qd, 136, 16 * mt, 32 * kk, lane), bi[kk], a);
#pragma unroll
                    for (int ks = 0; ks < 2; ++ks) a = mma16(ldfrag(Pm, 72, 16 * mt, 32 * ks, lane), ldfrag(vT, 72, 16 * nt, 32 * ks, lane), a);
                    acc[i] = a; }
#pragma unroll
                for (int i = 0; i < 2; ++i)
#pragma unroll
                    for (int e = 0; e < 4; ++e) { const int tok = 16 * (2 * (wave >> 2) + i) + 4 * q4 + e; float s1 = acc[i][e], s2 = s1 * s1;
                        s1 += shx(s1, 1, lane); s2 += shx(s2, 1, lane); s1 += shx(s1, 2, lane); s2 += shx(s2, 2, lane); s1 += shx(s1, 4, lane); s2 += shx(s2, 4, lane); s1 += shx(s1, 8, lane); s2 += shx(s2, 8, lane);
                        if (r16 == 0) { red[(nt * 64 + tok) * 2] = s1; red[(nt * 64 + tok) * 2 + 1] = s2; } }
                __syncthreads();
                { const int vc = 16 * nt + r16; const float gg = p->in[10][l * 256 + h * 64 + vc], gb = p->in[11][l * 256 + h * 64 + vc];
#pragma unroll
                  for (int i = 0; i < 2; ++i)
#pragma unroll
                      for (int e = 0; e < 4; ++e) { const int tok = 16 * (2 * (wave >> 2) + i) + 4 * q4 + e; float s1 = 0.f, s2 = 0.f;
#pragma unroll
                          for (int w = 0; w < 4; ++w) { s1 += red[(w * 64 + tok) * 2]; s2 += red[(w * 64 + tok) * 2 + 1]; }
                          const float mean = s1 * (1.f / 64.f), var = fmaxf(s2 * (1.f / 64.f) - mean * mean, 0.f), rstd = rsqrtf(var + LN_EPS_F);
                          const float sg = bf2f(Pb[(size_t)(R0 + tok) * PBC + 2304 + h * 64 + vc]);
                          Mx[(size_t)(R0 + tok) * 1024 + 512 + h * 64 + vc] = f2bf(((acc[i][e] - mean) * rstd * gg + gb) * sg); } }
                __syncthreads();
            }
      } }
    { const int tid = opaque_tid(), lane = tid & 63, wave = tid >> 6, q4 = lane >> 4, r16 = lane & 15; (void)wave; (void)tid;
      for (int it = (blockIdx.x + G - 80 % G) % G; it < N_S5; it += G) {
            const int t2 = it, b = t2 / 272, sc = (t2 % 272) >> 4, g = t2 & 15, R0 = b * TPB + sc * 256;
            v8s a[16];
#pragma unroll
            for (int ks = 0; ks < 8; ++ks) a[ks] = *(const v8s*)(Pb + (size_t)(R0 + r16 * 16 + 2 * ks + (q4 >> 1)) * PBC + 2560 + g * 16 + 8 * (q4 & 1));
#pragma unroll
            for (int d = 0; d < 2; ++d)
#pragma unroll
                for (int ks = 0; ks < 4; ++ks) a[8 + d * 4 + ks] = *(const v8s*)(HS + ((size_t)((b * 16 + g) * 2 + d) * NBLK + sc * 16 + r16) * 128 + 32 * ks + 8 * q4);
#pragma unroll
            for (int i = 0; i < 2; ++i) { const int nt = 2 * wave + i; v4f acc = {0.f, 0.f, 0.f, 0.f};
                const u16* bt = (const u16*)(p->ws + WS_BTY) + ((size_t)(l * 16 + g) * 256 + 16 * nt + r16) * 512 + 8 * q4;
#pragma unroll
                for (int ks = 0; ks < 16; ++ks) acc = mma16(a[ks], *(const v8s*)(bt + 32 * ks), acc);
                const int ch = g * 16 + r16; const float dd = p->in[19][l * 256 + ch];
#pragma unroll
                for (int e = 0; e < 4; ++e) { const int row = R0 + (4 * q4 + e) * 16 + nt; const float uv = bf2f(Pb[(size_t)row * PBC + 2560 + ch]);
                    S5G[(size_t)row * 256 + ch] = f2bf(gelu_tanh(acc[e] + dd * uv)); } }
      } }
}

__device__ __forceinline__ void ln_rows(v4f (&v)[4], const float* g, const float* bta, int lane) {
    float s = 0.f;
#pragma unroll
    for (int j = 0; j < 4; ++j) s += (v[j][0] + v[j][1]) + (v[j][2] + v[j][3]);
    const float mean = wave_sum(s, lane) * (1.f / 1024.f); float q = 0.f;
#pragma unroll
    for (int j = 0; j < 4; ++j) { const v4f d = v[j] - mean; q += (d[0] * d[0] + d[1] * d[1]) + (d[2] * d[2] + d[3] * d[3]); }
    const float rstd = rsqrtf(wave_sum(q, lane) * (1.f / 1024.f) + LN_EPS_F);
#pragma unroll
    for (int j = 0; j < 4; ++j) { const int col = 4 * lane + 256 * j; const v4f gg = *(const v4f*)(g + col), bb = *(const v4f*)(bta + col); v[j] = (v[j] - mean) * rstd * gg + bb; }
}

__device__ PHASE_INLINE void ln1_phase(KP p, int l, unsigned char* smem) {
    const int tid = opaque_tid(), lane = tid & 63, wave = tid >> 6, G = gridDim.x, RPW = (NTOK + G - 1) / G;
    float* X = (float*)(p->ws + WS_X); u16* H = (u16*)(p->ws + WS_H);
    const float* MOD = (const float*)(p->ws + WS_TAB + TAB_MOD) + (size_t)l * 5 * 6144;
    int* tokE = (int*)(p->ws + WS_ROUTE + RT_TOKE); float* tokW = (float*)(p->ws + WS_ROUTE + RT_TOKW); int* tokP = (int*)(p->ws + WS_ROUTE + RT_TOKP);
    float* Wr = (float*)smem;
    int* lcnt = (int*)(smem + 81920); int* gbase = lcnt + 16; int* recE = lcnt + 32; int* recP = recE + 2048;
    for (int i = tid; i < 20480; i += NTHREADS) { const int o = i >> 10, k = i & 1023; Wr[i] = o < 4 ? p->in[27][(size_t)(l * 1024 + k) * 4 + o] : p->in[29][(size_t)(l * 1024 + k) * 16 + (o - 4)]; }
    if (tid < 16) lcnt[tid] = 0;
    __syncthreads();
    const float* lg = p->in[23] + l * 1024; const float* lb = p->in[24] + l * 1024;
    for (int i = wave; i < RPW; i += 8) { const int r = blockIdx.x * RPW + i; if (r >= NTOK) break;
        const int mi = mod_index(r); const float* md = MOD + (size_t)mi * 6144;
        v4f v[4];
#pragma unroll
        for (int j = 0; j < 4; ++j) v[j] = *(const v4f*)(X + (size_t)r * DM + 4 * lane + 256 * j);
        ln_rows(v, lg, lb, lane);
        v4f hv[4];
#pragma unroll
        for (int j = 0; j < 4; ++j) { const int col = 4 * lane + 256 * j; *(v4f*)(X + (size_t)r * DM + col) = v[j];
            const v4f sh = *(const v4f*)(md + 3072 + col), s2 = *(const v4f*)(md + 4096 + col); hv[j] = v[j] * (1.f + s2) + sh;
            v2u w; w.x = pk2(hv[j][0], hv[j][1]); w.y = pk2(hv[j][2], hv[j][3]); *(v2u*)(H + (size_t)r * DM + col) = w; }
        v4f L0, L1, L2, L3, L4;
#define RDOT(o) ({ float s_ = 0.f; _Pragma("unroll") for (int j = 0; j < 4; ++j) { const v4f wv = *(const v4f*)(Wr + (o) * 1024 + 4 * lane + 256 * j); s_ += (hv[j][0] * wv[0] + hv[j][1] * wv[1]) + (hv[j][2] * wv[2] + hv[j][3] * wv[3]); } wave_sum(s_, lane); })
        L0[0] = RDOT(0); L0[1] = RDOT(1); L0[2] = RDOT(2); L0[3] = RDOT(3);
        L1[0] = RDOT(4); L1[1] = RDOT(5); L1[2] = RDOT(6); L1[3] = RDOT(7);
        L2[0] = RDOT(8); L2[1] = RDOT(9); L2[2] = RDOT(10); L2[3] = RDOT(11);
        L3[0] = RDOT(12); L3[1] = RDOT(13); L3[2] = RDOT(14); L3[3] = RDOT(15);
        L4[0] = RDOT(16); L4[1] = RDOT(17); L4[2] = RDOT(18); L4[3] = RDOT(19);
#undef RDOT
        const float* rgb = p->in[28] + l * 4;
        const float g0 = L0[0] + rgb[0], g1 = L0[1] + rgb[1], g2 = L0[2] + rgb[2], g3 = L0[3] + rgb[3];
        int gi = 0; float gm = g0;
        if (g1 > gm) { gm = g1; gi = 1; } if (g2 > gm) { gm = g2; gi = 2; } if (g3 > gm) { gm = g3; gi = 3; }
        const float gp = 1.f / (__expf(g0 - gm) + __expf(g1 - gm) + __expf(g2 - gm) + __expf(g3 - gm));
        v4f el = L1; if (gi == 1) el = L2; if (gi == 2) el = L3; if (gi == 3) el = L4;
        const float* reb = p->in[30] + l * 16 + gi * 4;
        const float e0 = el[0] + reb[0], e1 = el[1] + reb[1], e2 = el[2] + reb[2], e3 = el[3] + reb[3];
        int i0 = 0; float m0 = e0;
        if (e1 > m0) { m0 = e1; i0 = 1; } if (e2 > m0) { m0 = e2; i0 = 2; } if (e3 > m0) { m0 = e3; i0 = 3; }
        int i1 = -1; float m1 = -3.0e38f;
        if (i0 != 0 && e0 > m1) { m1 = e0; i1 = 0; } if (i0 != 1 && e1 > m1) { m1 = e1; i1 = 1; } if (i0 != 2 && e2 > m1) { m1 = e2; i1 = 2; } if (i0 != 3 && e3 > m1) { m1 = e3; i1 = 3; }
        if (i1 < 0) { i1 = (i0 + 1) & 3; m1 = m0; }
        const float ex = __expf(m1 - m0), w0 = gp / (1.f + ex), w1 = gp * ex / (1.f + ex);
        const int E0 = gi * 4 + i0, E1 = gi * 4 + i1;
        if (lane == 0) { const int lp0 = atomicAdd(&lcnt[E0], 1), lp1 = atomicAdd(&lcnt[E1], 1);
            recE[2 * i] = E0; recE[2 * i + 1] = E1; recP[2 * i] = lp0; recP[2 * i + 1] = lp1;
            tokE[2 * r] = E0; tokE[2 * r + 1] = E1; tokW[2 * r] = w0; tokW[2 * r + 1] = w1; }
    }
    __syncthreads();
    if (tid < 16) gbase[tid] = (int)__hip_atomic_fetch_add((unsigned*)(p->ws + WS_CTL) + CW_CNT + l * 16 + tid, (unsigned)lcnt[tid], __ATOMIC_RELAXED, __HIP_MEMORY_SCOPE_AGENT);
    __syncthreads();
    for (int i = tid; i < 2 * RPW; i += NTHREADS) { const int r = blockIdx.x * RPW + (i >> 1); if (r < NTOK) tokP[2 * r + (i & 1)] = gbase[recE[i]] + recP[i]; }
    __syncthreads();
}

__device__ __forceinline__ void moe_tables(KP p, int l, int* cntl, int* base, int* tileE, int* nT) {
    const int tid = opaque_tid();
    if (tid < 16) cntl[tid] = (int)__hip_atomic_load((unsigned*)(p->ws + WS_CTL) + CW_CNT + l * 16 + tid, __ATOMIC_RELAXED, __HIP_MEMORY_SCOPE_AGENT);
    __syncthreads();
    if (tid < 192) { int ts = 0, myE = -1;
#pragma unroll
        for (int e = 0; e < 16; ++e) { const int n = (cntl[e] + 255) >> 8; if (tid < 16 && e == tid) base[tid] = ts * 256; if (tid >= ts && tid < ts + n) myE = e; ts += n; }
        if (myE >= 0) tileE[tid] = myE;
        if (tid == 0) { base[16] = ts * 256; *nT = ts; } }
    __syncthreads();
}

__device__ PHASE_INLINE void gather_phase(KP p, int l, int* cntl, int* base, int* tileE, int* nT) {
    const int tid = opaque_tid(), lane = tid & 63, wave = tid >> 6, G = gridDim.x;
    moe_tables(p, l, cntl, base, tileE, nT);
    const u16* H = (const u16*)(p->ws + WS_H); u16* HSO = (u16*)(p->ws + WS_HSORT);
    const int* tokE = (const int*)(p->ws + WS_ROUTE + RT_TOKE); const float* tokW = (const float*)(p->ws + WS_ROUTE + RT_TOKW); const int* tokP = (const int*)(p->ws + WS_ROUTE + RT_TOKP);
    int* rinfo = (int*)(p->ws + WS_ROUTE + RT_RINFO); float* roww = (float*)(p->ws + WS_ROUTE + RT_ROWW);
    for (int r = blockIdx.x * 8 + wave; r < NTOK; r += G * 8) {
        int rr0 = base[tokE[2 * r] & 15] + tokP[2 * r], rr1 = base[tokE[2 * r + 1] & 15] + tokP[2 * r + 1];
        rr0 = min(max(rr0, 0), MOEROWS - 1); rr1 = min(max(rr1, 0), MOEROWS - 1);
        const pg8::u32x4 a = *(const pg8::u32x4*)(H + (size_t)r * DM + lane * 16), bq = *(const pg8::u32x4*)(H + (size_t)r * DM + lane * 16 + 8);
        *(pg8::u32x4*)(HSO + (size_t)rr0 * DM + lane * 16) = a; *(pg8::u32x4*)(HSO + (size_t)rr0 * DM + lane * 16 + 8) = bq;
        *(pg8::u32x4*)(HSO + (size_t)rr1 * DM + lane * 16) = a; *(pg8::u32x4*)(HSO + (size_t)rr1 * DM + lane * 16 + 8) = bq;
        if (lane == 0) { rinfo[rr0] = 2 * r; rinfo[rr1] = 2 * r + 1; roww[rr0] = tokW[2 * r]; roww[rr1] = tokW[2 * r + 1]; }
    }
    for (int e = blockIdx.x; e < 16; e += G)
        for (int rr = base[e] + cntl[e] + tid; rr < base[e + 1]; rr += NTHREADS) { rinfo[rr] = -1; roww[rr] = 0.f; }
}

__device__ PHASE_INLINE void ln2_phase(KP p, int l) {
    const int tid = opaque_tid(), lane = tid & 63, wave = tid >> 6, G = gridDim.x;
    float* X = (float*)(p->ws + WS_X); u16* H = (u16*)(p->ws + WS_H); const float* Y2 = (const float*)(p->ws + WS_Y2);
    const float* MOD = (const float*)(p->ws + WS_TAB + TAB_MOD) + (size_t)l * 5 * 6144;
    const float* lg = p->in[25] + l * 1024; const float* lb = p->in[26] + l * 1024;
    const bool last = (l == DEPTH - 1);
    for (int r = blockIdx.x * 8 + wave; r < NTOK; r += G * 8) {
        const int b = r / TPB, t = r - b * TPB; const int mi = t < CTXL ? 4 : b; const float* md = MOD + (size_t)mi * 6144;
        if (last && t < CTXL) continue;
        v4f v[4];
#pragma unroll
        for (int j = 0; j < 4; ++j) { const int col = 4 * lane + 256 * j; const v4f x = *(const v4f*)(X + (size_t)r * DM + col), g2 = *(const v4f*)(md + 5120 + col);
            const v4f ya = *(const v4f*)(Y2 + (size_t)r * DM + col), yb = *(const v4f*)(Y2 + ((size_t)NTOK + r) * DM + col);
            v[j] = x * ALPHA_F + g2 * (ya + yb); }
        ln_rows(v, lg, lb, lane);
        if (last) {
#pragma unroll
            for (int j = 0; j < 4; ++j) *(v4f*)(p->out + ((size_t)b * SEQ + (t - CTXL)) * DM + 4 * lane + 256 * j) = v[j];
        } else { const float* mn = md + 5 * 6144;
#pragma unroll
            for (int j = 0; j < 4; ++j) { const int col = 4 * lane + 256 * j; *(v4f*)(X + (size_t)r * DM + col) = v[j];
                const v4f sh = *(const v4f*)(mn + col), s1 = *(const v4f*)(mn + 1024 + col); const v4f hv = v[j] * (1.f + s1) + sh;
                v2u w; w.x = pk2(hv[0], hv[1]); w.y = pk2(hv[2], hv[3]); *(v2u*)(H + (size_t)r * DM + col) = w; } }
    }
}
#ifndef PROBE
#define PROBE 0
#endif
__device__ __forceinline__ void dump_f32(KP p, const float* src, size_t n) { const int tid = opaque_tid(); for (size_t i = (size_t)blockIdx.x * NTHREADS + tid; i < (size_t)16777216; i += (size_t)gridDim.x * NTHREADS) { float s = 0.f; for (size_t j = i; j < n; j += 16777216) s += src[j]; p->out[i] = s; } }
__device__ __forceinline__ void dump_bf16(KP p, const u16* src, size_t n) { const int tid = opaque_tid(); for (size_t i = (size_t)blockIdx.x * NTHREADS + tid; i < (size_t)16777216; i += (size_t)gridDim.x * NTHREADS) { float s = 0.f; for (size_t j = i; j < n; j += 16777216) s += bf2f(src[j]); p->out[i] = s; } }
#define PROBE_F32(k, off, n) if constexpr (PROBE == (k)) { if (l == 0) { GRID_BAR(); dump_f32(kparams(), (const float*)(kparams()->ws + (off)), (size_t)(n)); return; } }
#define PROBE_BF16(k, off, n) if constexpr (PROBE == (k)) { if (l == 0) { GRID_BAR(); dump_bf16(kparams(), (const u16*)(kparams()->ws + (off)), (size_t)(n)); return; } }
__global__ void __launch_bounds__(NTHREADS, 2) fwd_kernel(Params p_arg) {
    extern __shared__ __attribute__((aligned(16))) unsigned char shm[];
    const int tid = opaque_tid();
    LAS unsigned char* ldsp = (LAS unsigned char*)shm;
    volatile LAS unsigned* misc = (volatile LAS unsigned*)(ldsp + LDS_MISC);
    if (tid < 64) misc[tid] = 0u;
    __syncthreads();
    (void)xcd_barrier_post((unsigned*)(p_arg.ws + WS_CTL) + CW_BAR, misc + 8);
#define GRID_BAR() do { XcdBarrier b_; b_.bar = (unsigned*)(kparams()->ws + WS_CTL) + CW_BAR; b_.x = xb_xcc_id(); b_.st = misc + 8; xcd_barrier(b_); } while (0)
    unsigned char* smem = shm;
    int* tileE = (int*)(shm + LDS_MISC + 1024); int* mbase = (int*)(shm + LDS_MISC + 2048); int* cntl = (int*)(shm + LDS_MISC + 2304); int* nTp = (int*)(shm + LDS_MISC + 2432);
    const int G = gridDim.x;

#ifndef GEMM_ALIGN
#define GEMM_ALIGN true
#endif
#ifndef GEMM_SP2
#define GEMM_SP2 true
#endif
#ifndef PHMASK
#define PHMASK 0xFFFF
#endif
#define PH(k) if constexpr ((PHMASK >> (k)) & 1)
    PH(0) p0_prologue(kparams(), smem);
    GRID_BAR();
    PH(1) p0b_init(kparams());
    { const int l = 0; PROBE_F32(1, WS_X, (size_t)NTOK * 1024) }
    GRID_BAR();

#ifdef UNROLL_LAYERS
#pragma unroll
#endif
    for (int l = 0; l < DEPTH; ++l) {
        PH(2) { KP p = kparams(); const float* TABf = (const float*)(p->ws + WS_TAB); pg8::Gemm g{(const pg8::bf16_t*)(p->ws + WS_H), (const pg8::bf16_t*)(p->ws + WS_WIN), NTOK, INC, DM};
          pg8::StaticOrder S; S.init(NTOK, INC, G, (int)blockIdx.x);
          EpiIn E{(u16*)(p->ws + WS_PB), (float*)(p->ws + WS_LF), TABf + TAB_LB / 4 + l * 1024, TABf + TAB_ROPE / 4};
          pg8::gemm_phase<EpiIn, pg8::StaticOrder, GEMM_ALIGN, GEMM_SP2>(ldsp, g, S, E); }
        PROBE_BF16(2, WS_PB, (size_t)NTOK * PBC) PROBE_F32(12, WS_LF, (size_t)NTOK * 1024)
        GRID_BAR();
        PH(3) sc1_phase(kparams(), l, smem);
        PROBE_BF16(3, WS_SB, (size_t)2176 * 16384) PROBE_BF16(13, WS_RB, (size_t)2176 * 4096) PROBE_F32(23, WS_E, (size_t)128 * 272 * 128) PROBE_F32(33, WS_SA, (size_t)2176 * 128)
        GRID_BAR();
        PH(4) sc2_phase(kparams(), l, smem);
        PROBE_BF16(4, WS_SB, (size_t)2176 * 16384) PROBE_BF16(14, WS_RB, (size_t)2176 * 4096) PROBE_BF16(24, WS_HS, (size_t)128 * 272 * 128)
        GRID_BAR();
        PH(5) sc3_phase(kparams(), l, smem);
        PROBE_BF16(15, WS_S5G, (size_t)NTOK * 256)
        GRID_BAR();
        PH(6) { KP p = kparams(); int kglu = 256; asm volatile("" : "+s"(kglu)); pg8::Gemm g{(const pg8::bf16_t*)(p->ws + WS_S5G), (const pg8::bf16_t*)(p->ws + WS_GLUW) + (size_t)l * 256 * 256, NTOK, 256, kglu};
          pg8::StaticOrder S; S.init(NTOK, 256, G, (int)blockIdx.x);
          EpiGlu E{(const u16*)(p->ws + WS_S5G), (u16*)(p->ws + WS_MX), p->in[21] + l * 256};
          pg8::gemm_phase<EpiGlu, pg8::StaticOrder, GEMM_ALIGN, GEMM_SP2>(ldsp, g, S, E); }
        PROBE_BF16(6, WS_MX, (size_t)NTOK * 1024)
        GRID_BAR();
        PH(7) { KP p = kparams(); const float* TABf = (const float*)(p->ws + WS_TAB); pg8::Gemm g{(const pg8::bf16_t*)(p->ws + WS_MX), (const pg8::bf16_t*)(p->ws + WS_WOUT), NTOK, DM, DM};
          pg8::StaticOrder S; S.init(NTOK, DM, G, (int)blockIdx.x);
          EpiOut E{(float*)(p->ws + WS_X), TABf + TAB_MOD / 4 + (size_t)l * 5 * 6144};
          pg8::gemm_phase<EpiOut, pg8::StaticOrder, GEMM_ALIGN, GEMM_SP2>(ldsp, g, S, E); }
        PROBE_F32(7, WS_X, (size_t)NTOK * 1024)
        GRID_BAR();
        PH(8) ln1_phase(kparams(), l, smem);
        PROBE_F32(8, WS_X, (size_t)NTOK * 1024)
        GRID_BAR();
        PH(9) gather_phase(kparams(), l, cntl, mbase, tileE, nTp);
        GRID_BAR();
        PH(10) { KP p = kparams(); moe_tables(p, l, cntl, mbase, tileE, nTp);
          pg8::Gemm g{(const pg8::bf16_t*)(p->ws + WS_HSORT), (const pg8::bf16_t*)(p->ws + WS_WGU), MOEROWS, 16 * 1024, DM};
          MoeOrder S{tileE, *nTp, G, (int)blockIdx.x};
          EpiGU E{(u16*)(p->ws + WS_HID)};
          pg8::gemm_phase<EpiGU, MoeOrder, GEMM_ALIGN, GEMM_SP2>(ldsp, g, S, E); }
        GRID_BAR();
        PH(11) { KP p = kparams(); pg8::Gemm g{(const pg8::bf16_t*)(p->ws + WS_HID), (const pg8::bf16_t*)(p->ws + WS_WDN), MOEROWS, 16 * 1024, 512};
          MoeOrder S{tileE, *nTp, G, (int)blockIdx.x};
          EpiDown E{(float*)(p->ws + WS_Y2), (const int*)(p->ws + WS_ROUTE + RT_RINFO), (const float*)(p->ws + WS_ROUTE + RT_ROWW)};
          pg8::gemm_phase<EpiDown, MoeOrder, GEMM_ALIGN, GEMM_SP2>(ldsp, g, S, E); }
        PROBE_F32(9, WS_Y2, (size_t)2 * NTOK * 1024)
        GRID_BAR();
        PH(12) ln2_phase(kparams(), l);
        PROBE_F32(10, WS_X, (size_t)NTOK * 1024)
        if (l < DEPTH - 1) GRID_BAR();
    }
}

extern "C" void kernel_launch(void* const* d_in, const int* in_sizes, int n_in, void* d_out, int out_size, void* d_ws, size_t ws_size, hipStream_t stream) {
    static int grid = 0;
    if (grid == 0) {
        if (n_in != 34 || ws_size < WS_END) { fprintf(stderr, "kernel_launch: unexpected n_in %d or ws %zu < %zu\n", n_in, ws_size, (size_t)WS_END); grid = -1; return; }
        int dev = 0, cus = 0, per_cu = 0;
        if (hipGetDevice(&dev) != hipSuccess || hipDeviceGetAttribute(&cus, hipDeviceAttributeMultiprocessorCount, dev) != hipSuccess) { grid = -1; return; }
        if (hipFuncSetAttribute((const void*)fwd_kernel, hipFuncAttributeMaxDynamicSharedMemorySize, LDS_BYTES) != hipSuccess) { fprintf(stderr, "kernel_launch: hipFuncSetAttribute failed\n"); grid = -1; return; }
        if (hipOccupancyMaxActiveBlocksPerMultiprocessor(&per_cu, (const void*)fwd_kernel, NTHREADS, LDS_BYTES) != hipSuccess || per_cu < 1) { fprintf(stderr, "kernel_launch: occupancy query says %d\n", per_cu); }
        (void)hipGetLastError();
        grid = cus;
    }
    if (grid < 0) return;
    (void)in_sizes; (void)out_size;
    if (hipMemsetAsync((char*)d_ws + WS_CTL, 0, CTL_BYTES, stream) != hipSuccess) { fprintf(stderr, "kernel_launch: memset failed\n"); return; }
    Params p{};
    for (int i = 0; i < 34; ++i) p.in[i] = (const float*)d_in[i];
    p.out = (float*)d_out; p.ws = (unsigned char*)d_ws;
    hipLaunchKernelGGL(fwd_kernel, dim3(grid), dim3(NTHREADS), LDS_BYTES, stream, p);
}
```

```cpp
#include <hip/hip_runtime.h>
#include <cstdio>
#include <cstdint>
namespace pg8 {
#define PG8_LAS __attribute__((address_space(3)))
typedef unsigned short bf16_t;
typedef short bf16x8 __attribute__((ext_vector_type(8)));
typedef float f32x4 __attribute__((ext_vector_type(4)));
typedef unsigned u32x4 __attribute__((ext_vector_type(4)));
constexpr int BM = 256, BK = 64, HALF = 128, HTB = HALF * BK * 2  , STAGE_BYTES = 8 * HTB, NXCD = 8, WGM = 8;

__host__ __device__ __forceinline__ int lds_byte(int r, int c) { const int st = (r >> 4) * 2 + (c >> 5), rr = r & 15, cc = c & 31, ob = rr * 64 + cc * 2; return st * 1024 + (ob ^ (((ob >> 9) & 1) << 5)); }
__host__ __device__ __forceinline__ void stage_rc(int b, int& R, int& C) { const int st = b / 1024, sb = b % 1024, swz = sb ^ (((sb >> 9) & 1) << 5); R = (st >> 1) * 16 + swz / 64; C = (st & 1) * 32 + (swz % 64) / 2; }
__host__ __device__ __forceinline__ int perm32(int rho) { const int n = rho >> 4, i = rho & 15; return 8 * (i >> 2) + 4 * n + (i & 3); }

struct Unit { int pm, pn; };
struct Gemm { const bf16_t* A; const bf16_t* Bt; int M, N, K; };

struct StaticOrder {
    int nM, nN, nwg, G, c;
    __host__ __device__ void init(int M, int N, int G_, int c_) { nM = M / BM; nN = N / BM; nwg = nM * nN; G = G_; c = c_; }
    __host__ __device__ bool next(int i, Unit& u) const {
        const long L = (long)i * G + c; if (L >= nwg) return false;
        int wgid = (int)L; { const int q = nwg / NXCD, r = nwg % NXCD, xcd = wgid % NXCD, off = wgid / NXCD; wgid = (xcd < r ? xcd * (q + 1) : r * (q + 1) + (xcd - r) * q) + off; }
        const int nig = WGM * nN, gid = wgid / nig, fm = gid * WGM, gsz = (nM - fm) < WGM ? (nM - fm) : WGM;
        u.pm = fm + ((wgid % nig) % gsz); u.pn = (wgid % nig) / gsz; return true;
    }
    __device__ __forceinline__ void a_ready(const Unit&) const {}
    __device__ __forceinline__ void done(const Unit&) const {}
};

__device__ __forceinline__ unsigned cvt_pk_bf16(float lo, float hi) { unsigned r; asm volatile("v_cvt_pk_bf16_f32 %0, %1, %2" : "=v"(r) : "v"(lo), "v"(hi)); return r; }
template <class Epi, class Sched, bool ALIGN_EPI = false, bool SP2 = false>
__device__ __forceinline__ void gemm_phase(PG8_LAS unsigned char* lds, const Gemm g, const Sched& S, const Epi& E) {
    int tid_ = threadIdx.x; asm volatile("" : "+v"(tid_));
    const int tid = tid_, wid = __builtin_amdgcn_readfirstlane(tid >> 6), lane = tid & 63, wr = wid >> 2, wc = wid & 3, fr = lane & 15, fq = lane >> 4;
    const int K = g.K, nt = K / BK;
    unsigned voffA[2], voffB[2];
#pragma unroll
    for (int i = 0; i < 2; ++i) { int R, C; stage_rc(tid * 16 + i * 8192, R, C); const int Rb = Epi::PERM ? ((R & ~31) + perm32(R & 31)) : R;
        voffA[i] = (unsigned)(R * K + C) * 2u; voffB[i] = (unsigned)(Rb * K + C) * 2u; }
    const size_t kstep = (size_t)(BK * 2);
    const size_t hstep = (size_t)HALF * K * 2;
    const size_t tstep = 2 * hstep;
    const unsigned ldsw = (unsigned)wid * 1024u;
    const int aoff = lds_byte(wr * 64 + fr, fq * 8), boff = lds_byte(wc * 32 + fr, fq * 8);
#define PG8_SA(b, h) (((b) * 2 + (h)) * HTB)
#define PG8_SB(b, h) ((4 + (b) * 2 + (h)) * HTB)
#define PG8_STAGE(bufoff, gbase, voff) do { _Pragma("unroll") for (int _i = 0; _i < 2; ++_i) \
        __builtin_amdgcn_global_load_lds((const unsigned*)((const char*)(gbase) + (voff)[_i]), (PG8_LAS unsigned*)(lds + (bufoff) + ldsw + _i * 8192), 16, 0, 0); } while (0)
#define PG8_LDA(dst, b, h) do { _Pragma("unroll") for (int m = 0; m < 4; ++m) _Pragma("unroll") for (int k = 0; k < 2; ++k) dst[m][k] = *(const PG8_LAS bf16x8*)(lds + PG8_SA(b, h) + aoff + m * 2048 + k * 1024); } while (0)
#define PG8_LDB(dst, b, h) do { _Pragma("unroll") for (int n = 0; n < 2; ++n) _Pragma("unroll") for (int k = 0; k < 2; ++k) dst[n][k] = *(const PG8_LAS bf16x8*)(lds + PG8_SB(b, h) + boff + n * 2048 + k * 1024); } while (0)
#define PG8_MMA(ai, bj, At, Bt) do { __builtin_amdgcn_s_setprio(1); _Pragma("unroll") for (int m = 0; m < 4; ++m) _Pragma("unroll") for (int n = 0; n < 2; ++n) _Pragma("unroll") for (int k = 0; k < 2; ++k) \
        acc[ai][bj][m][n] = __builtin_amdgcn_mfma_f32_16x16x32_bf16(Bt[n][k], At[m][k], acc[ai][bj][m][n], 0, 0, 0); __builtin_amdgcn_s_setprio(0); } while (0)
#define PG8_WAIT_V(n) asm volatile("s_waitcnt vmcnt(" #n ")" ::: "memory")
#define PG8_WAIT_L(n) asm volatile("s_waitcnt lgkmcnt(" #n ")" ::: "memory")
#define PG8_BAR __builtin_amdgcn_s_barrier()
#define PG8_SCHED __builtin_amdgcn_sched_barrier(0)
    Unit cur, nxt; int ui = 0;
    if (!S.next(0, cur)) return;
    f32x4 acc[2][2][4][2];
#pragma unroll
    for (int a = 0; a < 2; ++a)
#pragma unroll
        for (int b = 0; b < 2; ++b)
#pragma unroll
            for (int m = 0; m < 4; ++m)
#pragma unroll
                for (int n = 0; n < 2; ++n) acc[a][b][m][n] = (f32x4){0.f, 0.f, 0.f, 0.f};
    bf16x8 At[4][2], B0[2][2], B1[2][2];
    const char* cA = (const char*)g.A + (size_t)cur.pm * tstep; const char* cB = (const char*)g.Bt + (size_t)cur.pn * tstep;
    S.a_ready(cur);
    if constexpr (SP2) {
        PG8_STAGE(PG8_SB(0, 0), cB, voffB); PG8_STAGE(PG8_SB(0, 1), cB + hstep, voffB); PG8_STAGE(PG8_SA(0, 0), cA, voffA); PG8_STAGE(PG8_SA(0, 1), cA + hstep, voffA);
        if (wr == 1) PG8_BAR;
        PG8_WAIT_V(2); PG8_BAR;
        PG8_STAGE(PG8_SB(1, 0), cB + kstep, voffB); PG8_STAGE(PG8_SA(1, 0), cA + kstep, voffA); PG8_STAGE(PG8_SB(1, 1), cB + hstep + kstep, voffB);
        PG8_WAIT_V(6); PG8_BAR;
    } else {
        PG8_STAGE(PG8_SB(0, 0), cB, voffB); PG8_STAGE(PG8_SA(0, 0), cA, voffA); PG8_STAGE(PG8_SB(0, 1), cB + hstep, voffB); PG8_STAGE(PG8_SA(0, 1), cA + hstep, voffA);
        if (wr == 1) PG8_BAR;
        PG8_WAIT_V(4); PG8_BAR;
        PG8_STAGE(PG8_SB(1, 0), cB + kstep, voffB); PG8_STAGE(PG8_SA(1, 0), cA + kstep, voffA); PG8_STAGE(PG8_SB(1, 1), cB + hstep + kstep, voffB);
        PG8_WAIT_V(6); PG8_BAR;
    }
    for (;;) {
        const bool has_next = S.next(ui + 1, nxt);
        const char* nA = has_next ? (const char*)g.A + (size_t)nxt.pm * tstep : cA; const char* nB = has_next ? (const char*)g.Bt + (size_t)nxt.pn * tstep : cB;
        for (int t = 0; t < nt; t += 2) {
            const bool last = (t == nt - 2);
            const char* a1 = cA + (size_t)(t + 1) * kstep;
            const char* a2 = last ? nA : cA + (size_t)(t + 2) * kstep; const char* b2 = last ? nB : cB + (size_t)(t + 2) * kstep;
            const char* a3 = a2 + kstep; const char* b3 = b2 + kstep;
            if (last && has_next) S.a_ready(nxt);
            if constexpr (SP2) {
            PG8_LDB(B0, 0, 0); PG8_LDB(B1, 0, 1); PG8_SCHED; PG8_LDA(At, 0, 0); PG8_STAGE(PG8_SA(1, 1), a1 + hstep, voffA);
            PG8_WAIT_V(8); PG8_WAIT_L(0); PG8_BAR; PG8_MMA(0, 0, At, B0); PG8_MMA(0, 1, At, B1); PG8_BAR; PG8_SCHED;
            PG8_LDA(At, 0, 1); PG8_STAGE(PG8_SB(0, 0), b2, voffB); PG8_STAGE(PG8_SB(0, 1), b2 + hstep, voffB); PG8_STAGE(PG8_SA(0, 0), a2, voffA);
            PG8_WAIT_V(8); PG8_WAIT_L(0); PG8_BAR; PG8_MMA(1, 0, At, B0); PG8_MMA(1, 1, At, B1); PG8_BAR; PG8_SCHED;
            PG8_LDB(B0, 1, 0); PG8_LDB(B1, 1, 1); PG8_SCHED; PG8_LDA(At, 1, 0); PG8_STAGE(PG8_SA(0, 1), a2 + hstep, voffA);
            PG8_WAIT_V(8); PG8_WAIT_L(0); PG8_BAR; PG8_MMA(0, 0, At, B0); PG8_MMA(0, 1, At, B1); PG8_BAR; PG8_SCHED;
            PG8_LDA(At, 1, 1); PG8_STAGE(PG8_SB(1, 0), b3, voffB); PG8_STAGE(PG8_SB(1, 1), b3 + hstep, voffB); PG8_STAGE(PG8_SA(1, 0), a3, voffA);
            PG8_WAIT_V(8); PG8_WAIT_L(0); PG8_BAR; PG8_MMA(1, 0, At, B0); PG8_MMA(1, 1, At, B1); PG8_BAR; PG8_SCHED;
            } else {
            PG8_LDB(B0, 0, 0); PG8_SCHED; PG8_LDA(At, 0, 0); PG8_STAGE(PG8_SA(1, 1), a1 + hstep, voffA);
            PG8_WAIT_L(8); PG8_BAR; PG8_WAIT_L(0); PG8_MMA(0, 0, At, B0); PG8_BAR; PG8_SCHED;
            PG8_LDB(B1, 0, 1); PG8_STAGE(PG8_SB(0, 0), b2, voffB);
            PG8_BAR; PG8_WAIT_L(0); PG8_MMA(0, 1, At, B1); PG8_BAR;
            PG8_LDA(At, 0, 1); PG8_STAGE(PG8_SA(0, 0), a2, voffA);
            PG8_BAR; PG8_WAIT_L(0); PG8_MMA(1, 0, At, B0); PG8_BAR; PG8_SCHED;
            PG8_STAGE(PG8_SB(0, 1), b2 + hstep, voffB);
            PG8_WAIT_V(6); PG8_BAR; PG8_MMA(1, 1, At, B1); PG8_BAR;
            PG8_LDB(B0, 1, 0); PG8_SCHED; PG8_LDA(At, 1, 0); PG8_STAGE(PG8_SA(0, 1), a2 + hstep, voffA);
            PG8_WAIT_L(8); PG8_BAR; PG8_WAIT_L(0); PG8_MMA(0, 0, At, B0); PG8_BAR; PG8_SCHED;
            PG8_LDB(B1, 1, 1); PG8_STAGE(PG8_SB(1, 0), b3, voffB);
            PG8_BAR; PG8_WAIT_L(0); PG8_MMA(0, 1, At, B1); PG8_BAR;
            PG8_LDA(At, 1, 1); PG8_STAGE(PG8_SA(1, 0), a3, voffA);
            PG8_BAR; PG8_WAIT_L(0); PG8_MMA(1, 0, At, B0); PG8_BAR; PG8_SCHED;
            PG8_STAGE(PG8_SB(1, 1), b3 + hstep, voffB);
            PG8_WAIT_V(6); PG8_BAR; PG8_MMA(1, 1, At, B1); PG8_BAR;
            }
        }
        if constexpr (ALIGN_EPI) { if (wr == 0) PG8_BAR; }
        if constexpr (!Epi::AFTER_DRAIN) { E(acc, cur, wr, wc, fr, fq); S.done(cur); }
        if (!has_next) break;
#pragma unroll
        for (int a = 0; a < 2; ++a)
#pragma unroll
            for (int b = 0; b < 2; ++b)
#pragma unroll
                for (int m = 0; m < 4; ++m)
#pragma unroll
                    for (int n = 0; n < 2; ++n) acc[a][b][m][n] = (f32x4){0.f, 0.f, 0.f, 0.f};
        cur = nxt; cA = nA; cB = nB; ++ui;
        if constexpr (ALIGN_EPI) { if (wr == 1) PG8_BAR; }
    }
    PG8_WAIT_V(0);
    if constexpr (!ALIGN_EPI) { if (wr == 0) PG8_BAR; }
    PG8_BAR;
    if constexpr (Epi::AFTER_DRAIN) { E.fused(acc, cur, wr, wc, fr, fq, lds, wid, lane); S.done(cur); }
#undef PG8_SA
#undef PG8_SB
#undef PG8_STAGE
#undef PG8_LDA
#undef PG8_LDB
#undef PG8_MMA
#undef PG8_WAIT_V
#undef PG8_WAIT_L
#undef PG8_BAR
#undef PG8_SCHED
}
}
#define XB_TMO      128
#define XB_XCNT(j)  (256  + 64 * (j))
#define XB_XSUB(j)  (1280 + 64 * (j))
#define XB_XGEN(j)  (2304 + 64 * (j))
#define XB_TOP      3328
#define XB_TOPGEN   3392
#define XCD_BAR_WORDS 3456
#define XB_SPIN_CAP (1u << 18)
#define LAS __attribute__((address_space(3)))

__device__ __forceinline__ unsigned xb_ld(unsigned* p)              { return __hip_atomic_load(p, __ATOMIC_RELAXED, __HIP_MEMORY_SCOPE_AGENT); }
__device__ __forceinline__ unsigned xb_add(unsigned* p, unsigned v) { return __hip_atomic_fetch_add(p, v, __ATOMIC_RELAXED, __HIP_MEMORY_SCOPE_AGENT); }
__device__ __forceinline__ unsigned xb_xcc_id() { return (unsigned)__builtin_amdgcn_s_getreg((3 << 11) | 20) & 0xFu; }
#define XB_SPIN(cond, bar) do { unsigned _sp = 0; while (cond) { __builtin_amdgcn_s_sleep(1); \
    if ((++_sp & 255u) == 0u) { if (xb_ld(&(bar)[XB_TMO])) break; if (_sp > XB_SPIN_CAP) { atomicAdd(&(bar)[XB_TMO], 1u); break; } } } } while (0)

struct XcdBarrier {
    unsigned* bar; unsigned x;
    volatile LAS unsigned* st;
};

__device__ __forceinline__ XcdBarrier xcd_barrier_post(unsigned* bar, volatile LAS unsigned* st) {
    XcdBarrier b; b.bar = bar; b.x = xb_xcc_id(); b.st = st;
    if (threadIdx.x == 0) (void)xb_add(&bar[XB_XCNT(b.x)], 1u);
    return b;
}
__device__ __forceinline__ void xcd_barrier_complete(unsigned* bar, unsigned x, unsigned& nloc, unsigned& nx) {
    const unsigned G = gridDim.x * gridDim.y * gridDim.z;
    unsigned sum, cnt, mine, sp = 0u;
    for (;;) {
        sum = 0u; cnt = 0u; mine = 0u;
#pragma unroll
        for (unsigned j = 0; j < 16; ++j) { const unsigned c = xb_ld(&bar[XB_XCNT(j)]); sum += c; cnt += (c > 0u) ? 1u : 0u; mine = (j == x) ? c : mine; }
        if (sum == G) break;
        __builtin_amdgcn_s_sleep(1);
        if ((++sp & 255u) == 0u) { if (xb_ld(&bar[XB_TMO])) break; if (sp > XB_SPIN_CAP) { atomicAdd(&bar[XB_TMO], 1u); break; } }
    }
    nloc = mine > 0u ? mine : 1u; nx = cnt > 0u ? cnt : 1u;
}

__device__ __forceinline__ void xcd_barrier(const XcdBarrier& b) {
    asm volatile("s_waitcnt vmcnt(0)" ::: "memory");
    __syncthreads();
    if (threadIdx.x == 0) {
        unsigned* bar = b.bar;
        __builtin_amdgcn_s_waitcnt(0);
        unsigned nloc = b.st[0], nx = b.st[1];
        if (nloc == 0u) { xcd_barrier_complete(bar, b.x, nloc, nx); b.st[0] = nloc; b.st[1] = nx; }
        const unsigned old = xb_add(&bar[XB_XSUB(b.x)], 1u);
        const unsigned gen = old / nloc;
        if (old + 1u == (gen + 1u) * nloc) {
            __builtin_amdgcn_fence(__ATOMIC_RELEASE, "agent");
            asm volatile("s_waitcnt vmcnt(0)" ::: "memory");
            const unsigned og = xb_add(&bar[XB_TOP], 1u);
            const unsigned tg = og / nx;
            if (og + 1u == (tg + 1u) * nx) xb_add(&bar[XB_TOPGEN], 1u);
            else XB_SPIN(xb_ld(&bar[XB_TOPGEN]) == tg, bar);
            __builtin_amdgcn_fence(__ATOMIC_ACQUIRE, "agent");
            xb_add(&bar[XB_XGEN(b.x)], 1u);
            asm volatile("s_waitcnt vmcnt(0)" ::: "memory");
        } else {
            XB_SPIN(xb_ld(&bar[XB_XGEN(b.x)]) == gen, bar);
            __builtin_amdgcn_fence(__ATOMIC_ACQUIRE, "agent");
            asm volatile("s_waitcnt vmcnt(0)" ::: "memory");
        }
    }
    __syncthreads();
}

#ifndef PHASE_INLINE
#define PHASE_INLINE __forceinline__
#endif
typedef unsigned short u16;
typedef short v8s __attribute__((ext_vector_type(8)));
typedef float v4f __attribute__((ext_vector_type(4)));
typedef unsigned v4u __attribute__((ext_vector_type(4)));
typedef unsigned v2u __attribute__((ext_vector_type(2)));

constexpr int DM = 1024, NB = 4, SEQ = 4096, CTXL = 256, TPB = SEQ + CTXL, NTOK = NB * TPB, DEPTH = 4;
constexpr int INC = 3840, PBC = 2816, NCH = 68, NBLK = 272, NSC = 17, MOEROWS = 38912;
constexpr float ALPHA_F = 1.681792830507429f;
constexpr float LN_EPS_F = 1e-5f;
constexpr int NTHREADS = 512;

constexpr size_t MiB = 1u << 20;
constexpr size_t WS_CTL = 0, CTL_BYTES = 1 * MiB;
constexpr size_t WS_TAB = 1 * MiB;
constexpr size_t TAB_MOD = 0, TAB_LB = 512 * 1024, TAB_ROPE = 544 * 1024, TAB_A16 = 576 * 1024, TAB_WRT = 704 * 1024;
constexpr size_t WS_GLUW = 2 * MiB, WS_BTE = 3 * MiB, WS_BTY = 11 * MiB, WS_WIN = 27 * MiB, WS_WOUT = 35 * MiB, WS_WGU = 37 * MiB, WS_WDN = 69 * MiB;
constexpr size_t WS_X = 85 * MiB, WS_H = 153 * MiB, WS_ROUTE = 187 * MiB, WS_SCR = 188 * MiB;
constexpr size_t RT_TOKE = 0, RT_TOKW = 160 * 1024, RT_TOKP = 320 * 1024, RT_RINFO = 480 * 1024, RT_ROWW = 640 * 1024;
constexpr size_t WS_PB = 188 * MiB, WS_LF = 282 * MiB, WS_SB = 350 * MiB, WS_SA = 418 * MiB, WS_RB = 420 * MiB, WS_E = 437 * MiB, WS_HS = 454 * MiB, WS_S5G = 463 * MiB, WS_MX = 472 * MiB;
constexpr size_t WS_HSORT = 188 * MiB, WS_HID = 264 * MiB, WS_Y2 = 302 * MiB;
constexpr size_t WS_WOUT2 = 506 * MiB;
constexpr size_t WS_END = 508 * MiB;
static_assert(WS_PB + (size_t)NTOK * PBC * 2 <= WS_LF && WS_LF + (size_t)NTOK * 1024 * 4 <= WS_SB && WS_SB + (size_t)2176 * 16384 * 2 <= WS_SA, "ws map 1");
static_assert(WS_SA + (size_t)2176 * 128 * 4 <= WS_RB && WS_RB + (size_t)2176 * 4096 * 2 <= WS_E && WS_E + (size_t)128 * 272 * 128 * 4 <= WS_HS, "ws map 2");
static_assert(WS_HS + (size_t)128 * 272 * 128 * 2 <= WS_S5G && WS_S5G + (size_t)NTOK * 256 * 2 <= WS_MX && WS_MX + (size_t)NTOK * 1024 * 2 <= WS_END, "ws map 3");
static_assert(WS_HSORT + (size_t)MOEROWS * 1024 * 2 <= WS_HID && WS_HID + (size_t)MOEROWS * 512 * 2 <= WS_Y2 && WS_Y2 + (size_t)2 * NTOK * 1024 * 4 <= WS_MX, "ws map 4");
static_assert(WS_X + (size_t)NTOK * 1024 * 4 <= WS_H && WS_H + (size_t)NTOK * 1024 * 2 <= WS_ROUTE, "ws map 5");
static_assert(WS_WIN + (size_t)INC * 1024 * 2 <= WS_WOUT && WS_WGU + (size_t)16 * 1024 * 1024 * 2 <= WS_WDN && WS_WDN + (size_t)16 * 1024 * 512 * 2 <= WS_X, "ws map 6");
constexpr int CW_TMO = 8, CW_BAR = 4096, CW_CNT = 16384, CW_Q = 20480, CW_TILE = 32768, TILE_WORDS = 16384;

constexpr int LDS_STAGE = 131072;
constexpr int LDS_MISC = LDS_STAGE;
constexpr int LDS_BYTES = 147456;

struct Params {
    const float* in[34];
    float* out;
    unsigned char* ws;
};

typedef const __attribute__((address_space(4))) Params* KP;
__device__ __forceinline__ KP kparams() { KP k = (KP)__builtin_amdgcn_kernarg_segment_ptr(); asm volatile("" : "+s"(k)); return k; }
__device__ __forceinline__ int OB() { int v = blockIdx.x; asm volatile("" : "+s"(v)); return v; }
__device__ __forceinline__ int OG() { int v = gridDim.x; asm volatile("" : "+s"(v)); return v; }
__device__ __forceinline__ int opaque_tid() { int t = threadIdx.x; asm volatile("" : "+v"(t)); return t; }
__device__ __forceinline__ float bf2f(u16 v) { return __uint_as_float(((unsigned)v) << 16); }
typedef __bf16 bf2_t __attribute__((ext_vector_type(2)));
typedef float fl2_t __attribute__((ext_vector_type(2)));
__device__ __forceinline__ unsigned pk2(float lo, float hi) { const fl2_t f = {lo, hi}; const bf2_t b = __builtin_convertvector(f, bf2_t); return __builtin_bit_cast(unsigned, b); }
__device__ __forceinline__ void st4bf(u16* p, v4f v) { v2u w; w.x = pk2(v[0], v[1]); w.y = pk2(v[2], v[3]); *(v2u*)p = w; }
__device__ __forceinline__ u16 f2bf(float f) { return (u16)(pk2(f, 0.f) & 0xffffu); }
typedef _Float16 h2_t __attribute__((ext_vector_type(2)));
__device__ __forceinline__ float2 ldh2(const u16* p) { const h2_t h = *(const h2_t*)p; return make_float2((float)h[0], (float)h[1]); }
__device__ __forceinline__ v4f ld4bf(const u16* p) { const v2u w = *(const v2u*)p; return (v4f){__uint_as_float(w.x << 16), __uint_as_float(w.x & 0xffff0000u), __uint_as_float(w.y << 16), __uint_as_float(w.y & 0xffff0000u)}; }
__device__ __forceinline__ void st4bf(u16* p, v4f v);
__device__ __forceinline__ unsigned pkh2(float lo, float hi) { const h2_t h = {(_Float16)lo, (_Float16)hi}; return __builtin_bit_cast(unsigned, h); }
__device__ __forceinline__ h2_t ash2(unsigned u) { return __builtin_bit_cast(h2_t, u); }
__device__ __forceinline__ v4f ld4h(const u16* p) { const v2u w = *(const v2u*)p; const unsigned wx = w.x, wy = w.y; const h2_t a = ash2(wx), b = ash2(wy); return (v4f){(float)a[0], (float)a[1], (float)b[0], (float)b[1]}; }
__device__ __forceinline__ void st4h(u16* p, v4f v) { v2u w; w.x = pkh2(v[0], v[1]); w.y = pkh2(v[2], v[3]); *(v2u*)p = w; }
__device__ __forceinline__ float sigm(float x) { return 1.f / (1.f + __expf(-x)); }
__device__ __forceinline__ float siluf(float x) { return x / (1.f + __expf(-x)); }
__device__ __forceinline__ float gelu_tanh(float x) { const float y = 0.7978845608028654f * (x + 0.044715f * x * x * x); const float t = 1.f - 2.f / (1.f + __expf(2.f * y)); return 0.5f * x * (1.f + t); }
__device__ __forceinline__ float shx(float v, int o, int lane) { return __int_as_float(__builtin_amdgcn_ds_bpermute((lane ^ o) << 2, __float_as_int(v))); }
__device__ __forceinline__ float wave_sum(float v, int lane) {
#pragma unroll
    for (int o = 32; o >= 1; o >>= 1) v += shx(v, o, lane);
    return v;
}
__device__ __forceinline__ v4f mma16(v8s a, v8s b, v4f c) { return __builtin_amdgcn_mfma_f32_16x16x32_bf16(a, b, c, 0, 0, 0); }
__device__ __forceinline__ v8s ldfrag(const u16* base, int pitch, int row0, int k0, int lane) { return *(const v8s*)(base + (size_t)(row0 + (lane & 15)) * pitch + k0 + 8 * (lane >> 4)); }
typedef short v4s __attribute__((ext_vector_type(4)));
__device__ __forceinline__ v8s trfrag(const unsigned char* base_generic, int pitchB, int col0, int k0, int lane) {
    LAS const char* base = (LAS const char*)base_generic;
    const int g = lane >> 4, q = (lane & 15) >> 2, pp = lane & 3;
    LAS const char* a = base + (k0 + 8 * g + q) * pitchB + col0 * 2 + 8 * pp;
    const v4s r0 = __builtin_amdgcn_ds_read_tr16_b64_v4i16((LAS v4s*)a), r1 = __builtin_amdgcn_ds_read_tr16_b64_v4i16((LAS v4s*)(a + 4 * pitchB));
    return (v8s){r0[0], r0[1], r0[2], r0[3], r1[0], r1[1], r1[2], r1[3]};
}
__device__ __forceinline__ float red_angle(float a) { return a - 6.283185307179586f * rintf(a * 0.15915494309189535f); }
__device__ __forceinline__ int mod_index(int row) { const int b = row / TPB; return (row - b * TPB) < CTXL ? 4 : b; }

struct WQ {
    unsigned* ctr; int* slot; bool dyn; int start, stride, par, cur;
    __device__ __forceinline__ void init(unsigned* c, int* s, bool d, int st, int sd, int tid) { ctr = c; slot = s; dyn = d; start = st; stride = sd; par = 0; cur = 0; (void)tid; }
    __device__ __forceinline__ int first(int tid) {
        if (!dyn) { cur = start; return cur; }
        if (tid == 0) slot[0] = (int)__hip_atomic_fetch_add(ctr, 1u, __ATOMIC_RELAXED, __HIP_MEMORY_SCOPE_AGENT);
        __syncthreads(); cur = slot[0]; par = 0; return cur; }
    __device__ __forceinline__ void prefetch(int tid) { if (dyn && tid == 0) slot[par ^ 1] = (int)__hip_atomic_fetch_add(ctr, 1u, __ATOMIC_RELAXED, __HIP_MEMORY_SCOPE_AGENT); }
    __device__ __forceinline__ int next(int tid) { (void)tid; if (!dyn) { cur += stride; return cur; } par ^= 1; cur = slot[par]; return cur; }
};

template <class CP> __device__ __forceinline__ void conv_tile(u16* dst, int ldd, int lds_, int n0, int k0, const CP& colptr, float* tile) {
    const int tid = opaque_tid(), lane = tid & 63, wave = tid >> 6;
    { const float* sp = colptr(n0 + lane) + (size_t)(k0 + wave) * lds_; float v[32];
#pragma unroll
      for (int r = 0; r < 32; ++r) v[r] = sp[(size_t)(r * 8) * lds_];
#pragma unroll
      for (int r = 0; r < 32; ++r) tile[(r * 8 + wave) * 65 + lane] = v[r]; }
    __syncthreads();
    { const int n = (wave << 3) | (lane & 7);
#pragma unroll
      for (int i = 0; i < 4; ++i) { const int ks = (i << 3) | (lane >> 3); float v[8];
#pragma unroll
          for (int j = 0; j < 8; ++j) v[j] = tile[(ks * 8 + j) * 65 + n];
          v4u w; w.x = pk2(v[0], v[1]); w.y = pk2(v[2], v[3]); w.z = pk2(v[4], v[5]); w.w = pk2(v[6], v[7]);
          *(v4u*)(dst + (size_t)(n0 + n) * ldd + k0 + ks * 8) = w; } }
    __syncthreads();
}
struct CpPlain { const float* base; __device__ __forceinline__ const float* operator()(int n) const { return base + n; } };
struct CpWin { const float* base; __device__ __forceinline__ const float* operator()(int n) const {
    int s = n; if (n >= 2560 && n < 3072) { const int n32 = n & 31, i = n32 >> 1; s = (n & ~31) + ((n32 & 1) ? 16 + i : i); } return base + s; } };
struct CpGU { const float* gate; long diff; __device__ __forceinline__ const float* operator()(int r) const {
    const int hidden = 4 * (r >> 3) + (r & 3); return gate + (long)((r >> 2) & 1) * diff + hidden; } };

__device__ __forceinline__ void conv_win(KP p, int l, int t, float* tile) {
    const int nt = t >> 2, kt = t & 3; CpWin cp{p->in[6] + (size_t)l * 1024 * INC};
    conv_tile((u16*)(p->ws + WS_WIN), 1024, INC, nt * 64, kt * 256, cp, tile);
}
__device__ __forceinline__ void conv_wout(KP p, int l, int t, float* tile) {
    const int nt = t >> 2, kt = t & 3; CpPlain cp{p->in[22] + (size_t)l * 1024 * 1024};
    conv_tile((u16*)(p->ws + ((l & 1) ? WS_WOUT2 : WS_WOUT)), 1024, 1024, nt * 64, kt * 256, cp, tile);
}
__device__ __forceinline__ void conv_wgu(KP p, int l, int t, float* tile) {
    const int e = t >> 6, nt = (t >> 2) & 15, kt = t & 3; const size_t eo = (size_t)(l * 16 + e) * 1024 * 512;
    CpGU cp{p->in[31] + eo, (long)(p->in[32] - p->in[31])};
    conv_tile((u16*)(p->ws + WS_WGU) + (size_t)e * 1024 * 1024, 1024, 512, nt * 64, kt * 256, cp, tile);
}
__device__ __forceinline__ void conv_wdn(KP p, int l, int t, float* tile) {
    const int e = t >> 5, nt = (t >> 1) & 15, kt = t & 1; CpPlain cp{p->in[33] + (size_t)(l * 16 + e) * 512 * 1024};
    conv_tile((u16*)(p->ws + WS_WDN) + (size_t)e * 1024 * 512, 512, 1024, nt * 64, kt * 256, cp, tile);
}

__device__ __forceinline__ void conv_tail(KP p, int l, unsigned char* smem) {
    const int G = OG(), c = OB(), nsec = (272 > G) ? (272 - G) : 0;
    if (c < nsec && G > nsec) return;
    const int idx = (G > nsec) ? c - nsec : c, stride = (G > nsec) ? G - nsec : G;
    const int nxt = (l < DEPTH - 1) ? 1 : 0, o_wdn = 1024, o_win = o_wdn + 512, o_wout = o_win + 240 * nxt, total = o_wout + 64 * nxt;
    for (int it = idx; it < total; it += stride) {
        if (it < o_wdn) conv_wgu(p, l, it, (float*)smem);
        else if (it < o_win) conv_wdn(p, l, it - o_wdn, (float*)smem);
        else if (it < o_wout) conv_win(p, l + 1, it - o_win, (float*)smem);
        else conv_wout(p, l + 1, it - o_wout, (float*)smem);
    }
}

__device__ PHASE_INLINE void p0_prologue(KP p, unsigned char* smem) {
    const int tid = opaque_tid(), lane = tid & 63, wave = tid >> 6, G = OG();
    float* TABf = (float*)(p->ws + WS_TAB);
    constexpr int N_MOD = 384, N_TAB = 17, N_S5 = 64, N_GLU = 16, N_WIN = 240, N_WOUT = 64;
    constexpr int O_TAB = N_MOD, O_S5 = O_TAB + N_TAB, O_GLU = O_S5 + N_S5, O_WIN = O_GLU + N_GLU, O_WOUT = O_WIN + N_WIN, TOTAL = O_WOUT + N_WOUT;
    for (int it = OB(); it < TOTAL; it += G) {
        if (it < O_TAB) {
            float* sc = (float*)smem; float* red = sc + 5120;
            for (int i = tid; i < 5120; i += NTHREADS) { const int r = i >> 10, k = i & 1023; const float cv = r < 4 ? p->in[1][r * 1024 + k] : p->in[3][k]; sc[i] = siluf(cv); }
            __syncthreads();
            const int l = it / 96, nb = it % 96, n = nb * 64 + lane;
            const float* wp = p->in[4] + (size_t)l * 1024 * 6144 + n;
            float a0 = 0.f, a1 = 0.f, a2 = 0.f, a3 = 0.f, a4 = 0.f;
#pragma unroll 8
            for (int k = wave * 128; k < wave * 128 + 128; ++k) { const float wv = wp[(size_t)k * 6144];
                a0 += sc[k] * wv; a1 += sc[1024 + k] * wv; a2 += sc[2048 + k] * wv; a3 += sc[3072 + k] * wv; a4 += sc[4096 + k] * wv; }
            red[(wave * 5 + 0) * 64 + lane] = a0; red[(wave * 5 + 1) * 64 + lane] = a1; red[(wave * 5 + 2) * 64 + lane] = a2; red[(wave * 5 + 3) * 64 + lane] = a3; red[(wave * 5 + 4) * 64 + lane] = a4;
            __syncthreads();
            if (tid < 320) { const int r = tid >> 6, ln = tid & 63; float s = 0.f;
#pragma unroll
                for (int w = 0; w < 8; ++w) s += red[(w * 5 + r) * 64 + ln];
                const int nn = nb * 64 + ln; TABf[TAB_MOD / 4 + (size_t)(l * 5 + r) * 6144 + nn] = s + p->in[5][l * 6144 + nn]; }
            __syncthreads();
        } else if (it < O_S5) {
            if (it > O_TAB) {
                for (int i = (it - O_TAB - 1) * 4096 + tid; i < (it - O_TAB) * 4096; i += NTHREADS) { const int ll = i >> 14, o = (i >> 9) & 31, k = (i & 511) * 2; float w0 = 0.f, w1 = 0.f;
                    if (o < 4) { w0 = p->in[27][(size_t)(ll * 1024 + k) * 4 + o]; w1 = p->in[27][(size_t)(ll * 1024 + k + 1) * 4 + o]; }
                    else if (o < 20) { w0 = p->in[29][(size_t)(ll * 1024 + k) * 16 + (o - 4)]; w1 = p->in[29][(size_t)(ll * 1024 + k + 1) * 16 + (o - 4)]; }
                    *(unsigned*)((u16*)(p->ws + WS_TAB + TAB_WRT) + (size_t)(ll * 32 + o) * 1024 + k) = pkh2(w0, w1); }
            } else {
            for (int i = tid; i < 1024; i += NTHREADS) {
                const float r0 = p->in[7][i], r1 = p->in[7][1024 + i], r2 = p->in[7][2048 + i], r3 = p->in[7][3072 + i];
                const float m = fmaxf(fmaxf(r0, r1), fmaxf(r2, r3));
                const float e0 = expf(r0 - m), e1 = expf(r1 - m), e2 = expf(r2 - m), e3 = expf(r3 - m), inv = 1.f / (e0 + e1 + e2 + e3);
                float* LB = TABf + TAB_LB / 4;
                LB[i] = 0.f; LB[1024 + i] = e1 * inv; LB[2048 + i] = (e1 + e2) * inv; LB[3072 + i] = (e1 + e2 + e3) * inv; }
            for (int i = tid; i < 1024; i += NTHREADS) { const int pos = i >> 4, k = i & 15;
                const float inv = exp2f(-(float)k * (13.287712379549449f / 16.f)); const float ang = red_angle((float)pos * inv);
                TABf[TAB_ROPE / 4 + 2 * i] = __cosf(ang); TABf[TAB_ROPE / 4 + 2 * i + 1] = __sinf(ang); }
            }
        } else if (it < O_GLU) {
            const int l = (it - O_S5) >> 4, g = (it - O_S5) & 15;
            float2* pw = (float2*)smem;
            float2* bbar = pw + 2 * 17 * 64;
            float2* cc = bbar + 2 * 64 * 16;
            float* Kt = (float*)(cc + 2 * 16 * 64);
            if (tid < 128) { const int d = tid >> 6, pp = tid & 63; const int pi = ((l * 2 + d) * 16 + g) * 64 + pp;
                const float lre = fminf(p->in[12][pi], -1e-4f), lim = p->in[13][pi], dt = expf(p->in[14][(l * 2 + d) * 16 + g]);
                for (int tau = 0; tau <= 16; ++tau) { const float mag = expf((float)tau * dt * lre), ang = red_angle((float)tau * dt * lim);
                    pw[(d * 17 + tau) * 64 + pp] = make_float2(mag * __cosf(ang), mag * __sinf(ang)); }
                const float2 ab = pw[(d * 17 + 1) * 64 + pp]; const float nr = ab.x - 1.f, ni = ab.y, den = lre * lre + lim * lim;
                const float cre = (nr * lre + ni * lim) / den, cim = (ni * lre - nr * lim) / den;
                ((float2*)(p->ws + WS_TAB + TAB_A16))[pi] = pw[(d * 17 + 16) * 64 + pp];
                for (int c = 0; c < 16; ++c) { const float br = p->in[15][(size_t)pi * 16 + c], bi = p->in[16][(size_t)pi * 16 + c];
                    bbar[(d * 64 + pp) * 16 + c] = make_float2(cre * br - cim * bi, cre * bi + cim * br); } }
            for (int i = tid; i < 2048; i += NTHREADS) { const int d = i >> 10, c = (i >> 6) & 15, pp = i & 63; const size_t ci = (size_t)(((l * 2 + d) * 16 + g) * 16 + c) * 64 + pp;
                cc[i] = make_float2(p->in[17][ci], p->in[18][ci]); }
            __syncthreads();
            for (int i = tid; i < 8192; i += NTHREADS) { const int d = i >> 12, tau = (i >> 8) & 15, c = (i >> 4) & 15, c2 = i & 15; float s = 0.f;
                for (int pp = 0; pp < 64; ++pp) { const float2 C = cc[(d * 16 + c) * 64 + pp], W = pw[(d * 17 + tau) * 64 + pp], Bv = bbar[(d * 64 + pp) * 16 + c2];
                    const float mx = C.x * W.x - C.y * W.y, my = C.x * W.y + C.y * W.x; s += mx * Bv.x - my * Bv.y; }
                Kt[i] = s; }
            __syncthreads();
            u16* BTY = (u16*)(p->ws + WS_BTY) + (size_t)(l * 16 + g) * 256 * 512;
            for (int pr = tid; pr < 65536; pr += NTHREADS) { const int n = pr >> 8, kk0 = (pr & 255) * 2, ti = n >> 4, c = n & 15; float v[2];
#pragma unroll
                for (int e = 0; e < 2; ++e) { const int kk = kk0 + e; float val;
                    if (kk < 256) { const int tj = kk >> 4, c2 = kk & 15; val = 0.f;
                        if (ti >= tj) val += Kt[((0 * 16 + (ti - tj)) * 16 + c) * 16 + c2];
                        if (ti <= tj) val += Kt[((1 * 16 + (tj - ti)) * 16 + c) * 16 + c2]; }
                    else { const int q = (kk - 256) >> 6, pp = kk & 63, d = q >> 1, tau = d ? 16 - ti : ti + 1;
                        const float2 C = cc[(d * 16 + c) * 64 + pp], W = pw[(d * 17 + tau) * 64 + pp];
                        val = (q & 1) ? -(C.x * W.y + C.y * W.x) : (C.x * W.x - C.y * W.y); }
                    v[e] = val; }
                *(unsigned*)(BTY + (size_t)n * 512 + kk0) = pk2(v[0], v[1]); }
            for (int pr = tid; pr < 32768; pr += NTHREADS) { const int d = pr >> 14, n = (pr >> 7) & 127, kk0 = (pr & 127) * 2, pp = n & 63, im = n >> 6; float v[2];
#pragma unroll
                for (int e = 0; e < 2; ++e) { const int kk = kk0 + e, tj = kk >> 4, c2 = kk & 15, tau = d ? tj : 15 - tj;
                    const float2 W = pw[(d * 17 + tau) * 64 + pp], Bv = bbar[(d * 64 + pp) * 16 + c2];
                    v[e] = im ? (W.x * Bv.y + W.y * Bv.x) : (W.x * Bv.x - W.y * Bv.y); }
                *(unsigned*)((u16*)(p->ws + WS_BTE) + ((size_t)((l * 2 + d) * 16 + g) * 128 + n) * 256 + kk0) = pk2(v[0], v[1]); }
            __syncthreads();
        } else if (it < O_WIN) {
            const int t = it - O_GLU, l = t >> 2, nt = t & 3; CpPlain cp{p->in[20] + (size_t)l * 256 * 256};
            conv_tile((u16*)(p->ws + WS_GLUW) + (size_t)l * 256 * 256, 256, 256, nt * 64, 0, cp, (float*)smem);
        } else if (it < O_WOUT) {
            conv_win(p, 0, it - O_WIN, (float*)smem);
        } else {
            conv_wout(p, 0, it - O_WOUT, (float*)smem);
        }
    }
}

__device__ PHASE_INLINE void p0b_init(KP p) {
    const int tid = opaque_tid(), lane = tid & 63, wave = tid >> 6, G = OG();
    const float* MOD = (const float*)(p->ws + WS_TAB + TAB_MOD);
    u16* X = (u16*)(p->ws + WS_X); u16* H = (u16*)(p->ws + WS_H);
    for (int r = OB() * 8 + wave; r < NTOK; r += G * 8) {
        const int b = r / TPB, t = r - b * TPB; const bool isc = t < CTXL; const int mi = isc ? 4 : b;
        const float* src = isc ? p->in[2] + (size_t)(b * CTXL + t) * DM : p->in[0] + (size_t)(b * SEQ + (t - CTXL)) * DM;
        const float* md = MOD + (size_t)(0 * 5 + mi) * 6144;
#pragma unroll
        for (int j = 0; j < 4; ++j) { const int col = 4 * lane + 256 * j; const v4f v = *(const v4f*)(src + col);
            st4h(X + (size_t)r * DM + col, v);
            const v4f sh = *(const v4f*)(md + col), s1 = *(const v4f*)(md + 1024 + col); const v4f h = v * (1.f + s1) + sh;
            v2u w; w.x = pk2(h[0], h[1]); w.y = pk2(h[2], h[3]); *(v2u*)(H + (size_t)r * DM + col) = w; }
    }
}
typedef pg8::f32x4 A4;
#define GAS __attribute__((address_space(1)))
struct EpiIn {
    static constexpr bool PERM = true, AFTER_DRAIN = false;
    u16* Pb; u16* LF; const float* lb; const float* rope;
    __device__ __forceinline__ void operator()(const A4 (&acc)[2][2][4][2], const pg8::Unit& u, int wr, int wc, int fr, int fq) const {
        const int pn = u.pn;
#pragma unroll
        for (int ai = 0; ai < 2; ++ai)
#pragma unroll
            for (int m = 0; m < 4; ++m) {
                asm volatile("" ::: "memory");
                const int row = u.pm * 256 + ai * 128 + wr * 64 + m * 16 + fr;
#pragma unroll
                for (int bj = 0; bj < 2; ++bj) {
                    A4 v0 = acc[ai][bj][m][0], v1 = acc[ai][bj][m][1];
                    const int col = pn * 256 + bj * 128 + wc * 32 + fq * 8;
                    if (pn >= 6 && pn <= 9) {
                        const int d = (pn - 6) >> 1, hc = col - 1536 - 512 * d;
                        const A4 l0 = *(const A4*)(lb + d * 512 + hc), l1 = *(const A4*)(lb + d * 512 + hc + 4);
                        float o[8];
#pragma unroll
                        for (int e = 0; e < 4; ++e) { o[e] = __logf(l0[e] + (1.f - l0[e]) * sigm(v0[e])); o[4 + e] = __logf(l1[e] + (1.f - l1[e]) * sigm(v1[e])); }
                        typedef _Float16 h2_t __attribute__((ext_vector_type(2)));
                        pg8::u32x4 w;
                        { const h2_t a = {(_Float16)o[0], (_Float16)o[1]}, bq = {(_Float16)o[2], (_Float16)o[3]}, cq = {(_Float16)o[4], (_Float16)o[5]}, dq = {(_Float16)o[6], (_Float16)o[7]};
                          w.x = __builtin_bit_cast(unsigned, a); w.y = __builtin_bit_cast(unsigned, bq); w.z = __builtin_bit_cast(unsigned, cq); w.w = __builtin_bit_cast(unsigned, dq); }
                        *(pg8::u32x4*)(LF + (size_t)row * 1024 + d * 512 + hc) = w;
                    } else {
                        int pc = col < 1536 ? col : col - 1024;
                        if (pn == 0 || pn == 1 || pn == 4 || pn == 5 || pn == 13) {
#pragma unroll
                            for (int e = 0; e < 4; ++e) { v0[e] = siluf(v0[e]); v1[e] = siluf(v1[e]); }
                        } else if (pn == 10 || pn == 11) {
                            const float sc = pn == 11 ? 0.125f : 1.f;
                            const int b = row / TPB, t = row - b * TPB;
                            if (t >= CTXL) {
                                const int tl = t - CTXL, pos = (wc & 1) ? (tl & 63) : (tl >> 6);
                                const A4 cs0 = *(const A4*)(rope + (pos * 16 + 4 * fq) * 2), cs1 = *(const A4*)(rope + (pos * 16 + 4 * fq + 2) * 2);
                                A4 r0, r1;
                                r0[0] = v0[0] * cs0[0] - v0[1] * cs0[1]; r0[1] = v0[0] * cs0[1] + v0[1] * cs0[0];
                                r0[2] = v0[2] * cs0[2] - v0[3] * cs0[3]; r0[3] = v0[2] * cs0[3] + v0[3] * cs0[2];
                                r1[0] = v1[0] * cs1[0] - v1[1] * cs1[1]; r1[1] = v1[0] * cs1[1] + v1[1] * cs1[0];
                                r1[2] = v1[2] * cs1[2] - v1[3] * cs1[3]; r1[3] = v1[2] * cs1[3] + v1[3] * cs1[2];
                                v0 = r0; v1 = r1;
                            }
                            v0 = v0 * sc; v1 = v1 * sc;
                        }
                        pg8::u32x4 w; w.x = pg8::cvt_pk_bf16(v0[0], v0[1]); w.y = pg8::cvt_pk_bf16(v0[2], v0[3]); w.z = pg8::cvt_pk_bf16(v1[0], v1[1]); w.w = pg8::cvt_pk_bf16(v1[2], v1[3]);
                        *(pg8::u32x4*)(Pb + (size_t)row * PBC + pc) = w;
                    }
                }
            }
    }
};
struct EpiGlu {
    static constexpr bool PERM = true, AFTER_DRAIN = false;
    const u16* S5G; u16* Mx; const float* bias;
    __device__ __forceinline__ void operator()(const A4 (&acc)[2][2][4][2], const pg8::Unit& u, int wr, int wc, int fr, int fq) const {
#pragma unroll
        for (int ai = 0; ai < 2; ++ai)
#pragma unroll
            for (int m = 0; m < 4; ++m) {
                asm volatile("" ::: "memory");
                const int row = u.pm * 256 + ai * 128 + wr * 64 + m * 16 + fr;
#pragma unroll
                for (int bj = 0; bj < 2; ++bj) {
                    const int col = bj * 128 + wc * 32 + fq * 8;
                    const A4 b0 = *(const A4*)(bias + col), b1 = *(const A4*)(bias + col + 4);
                    const A4 v0 = acc[ai][bj][m][0] + b0, v1 = acc[ai][bj][m][1] + b1;
                    const pg8::u32x4 sv = *(const pg8::u32x4*)(S5G + (size_t)row * 256 + col);
                    float s[8]; s[0] = __uint_as_float(sv.x << 16); s[1] = __uint_as_float(sv.x & 0xffff0000u); s[2] = __uint_as_float(sv.y << 16); s[3] = __uint_as_float(sv.y & 0xffff0000u);
                    s[4] = __uint_as_float(sv.z << 16); s[5] = __uint_as_float(sv.z & 0xffff0000u); s[6] = __uint_as_float(sv.w << 16); s[7] = __uint_as_float(sv.w & 0xffff0000u);
                    pg8::u32x4 w; w.x = pg8::cvt_pk_bf16(s[0] * sigm(v0[0]), s[1] * sigm(v0[1])); w.y = pg8::cvt_pk_bf16(s[2] * sigm(v0[2]), s[3] * sigm(v0[3]));
                    w.z = pg8::cvt_pk_bf16(s[4] * sigm(v1[0]), s[5] * sigm(v1[1])); w.w = pg8::cvt_pk_bf16(s[6] * sigm(v1[2]), s[7] * sigm(v1[3]));
                    *(pg8::u32x4*)(Mx + (size_t)row * 1024 + 768 + col) = w;
                }
            }
    }
};
struct EpiOut {
    static constexpr bool PERM = true, AFTER_DRAIN = false;
    const u16* X; u16* Xw; const float* mod;
    __device__ __forceinline__ void operator()(const A4 (&acc)[2][2][4][2], const pg8::Unit& u, int wr, int wc, int fr, int fq) const {
        const int b = u.pm / 17, mi = (u.pm - b * 17) == 0 ? 4 : b; const float* gp = mod + (size_t)mi * 6144 + 2048;
#pragma unroll
        for (int ai = 0; ai < 2; ++ai)
#pragma unroll
            for (int m = 0; m < 4; ++m) {
                asm volatile("" ::: "memory");
                const int row = u.pm * 256 + ai * 128 + wr * 64 + m * 16 + fr;
#pragma unroll
                for (int bj = 0; bj < 2; ++bj) {
                    const int col = u.pn * 256 + bj * 128 + wc * 32 + fq * 8; const u16* xp = X + (size_t)row * DM + col;
                    const A4 g0 = *(const A4*)(gp + col), g1 = *(const A4*)(gp + col + 4);
                    const pg8::u32x4 xw = *(const pg8::u32x4*)xp;
                    const unsigned u0 = xw.x, u1 = xw.y, u2 = xw.z, u3 = xw.w; const h2_t xa = ash2(u0), xb = ash2(u1), xc = ash2(u2), xd = ash2(u3);
                    const A4 x0 = {(float)xa[0], (float)xa[1], (float)xb[0], (float)xb[1]}, x1 = {(float)xc[0], (float)xc[1], (float)xd[0], (float)xd[1]};
                    const A4 z0 = x0 * ALPHA_F + g0 * acc[ai][bj][m][0], z1 = x1 * ALPHA_F + g1 * acc[ai][bj][m][1];
                    pg8::u32x4 o; o.x = pkh2(z0[0], z0[1]); o.y = pkh2(z0[2], z0[3]); o.z = pkh2(z1[0], z1[1]); o.w = pkh2(z1[2], z1[3]);
                    *(pg8::u32x4*)(Xw + (size_t)row * DM + col) = o;
                }
            }
    }
};
struct EpiGU {
    static constexpr bool PERM = true, AFTER_DRAIN = false;
    u16* Hid;
    __device__ __forceinline__ void operator()(const A4 (&acc)[2][2][4][2], const pg8::Unit& u, int wr, int wc, int fr, int fq) const {
#pragma unroll
        for (int ai = 0; ai < 2; ++ai)
#pragma unroll
            for (int m = 0; m < 4; ++m) {
                asm volatile("" ::: "memory");
                const int row = u.pm * 256 + ai * 128 + wr * 64 + m * 16 + fr;
#pragma unroll
                for (int bj = 0; bj < 2; ++bj) {
                    const int hc = (u.pn & 3) * 128 + bj * 64 + wc * 16 + fq * 4;
                    const A4 a = acc[ai][bj][m][0], bb = acc[ai][bj][m][1];
                    v2u w; w.x = pg8::cvt_pk_bf16(siluf(a[0]) * bb[0], siluf(a[1]) * bb[1]); w.y = pg8::cvt_pk_bf16(siluf(a[2]) * bb[2], siluf(a[3]) * bb[3]);
                    *(v2u*)(Hid + (size_t)row * 512 + hc) = w;
                }
            }
    }
};
struct EpiDown {
    static constexpr bool PERM = true, AFTER_DRAIN = false;
    u16* Y2; const int* rinfo; const float* roww;
    __device__ __forceinline__ void operator()(const A4 (&acc)[2][2][4][2], const pg8::Unit& u, int wr, int wc, int fr, int fq) const {
#pragma unroll
        for (int ai = 0; ai < 2; ++ai)
#pragma unroll
            for (int m = 0; m < 4; ++m) {
                asm volatile("" ::: "memory");
                const int prow = u.pm * 256 + ai * 128 + wr * 64 + m * 16 + fr;
                const int info = rinfo[prow];
                if (info >= 0) {
                    const float w = roww[prow]; u16* dst = Y2 + ((size_t)(info & 1) * NTOK + (info >> 1)) * DM;
#pragma unroll
                    for (int bj = 0; bj < 2; ++bj) { const int col = (u.pn & 3) * 256 + bj * 128 + wc * 32 + fq * 8;
                        const A4 v0 = acc[ai][bj][m][0] * w, v1 = acc[ai][bj][m][1] * w;
                        pg8::u32x4 o; o.x = pg8::cvt_pk_bf16(v0[0], v0[1]); o.y = pg8::cvt_pk_bf16(v0[2], v0[3]); o.z = pg8::cvt_pk_bf16(v1[0], v1[1]); o.w = pg8::cvt_pk_bf16(v1[2], v1[3]);
                        *(pg8::u32x4*)(dst + col) = o; }
                }
            }
    }
};
struct MoeOrder {
    const int* tileE; int nT, G, c;
    __device__ __forceinline__ bool next(int i, pg8::Unit& u) const { const int L = i * G + c; if (L >= nT * 4) return false; u.pm = L >> 2; u.pn = tileE[L >> 2] * 4 + (L & 3); return true; }
    __device__ __forceinline__ void a_ready(const pg8::Unit&) const {}
    __device__ __forceinline__ void done(const pg8::Unit&) const {}
};
struct LatOrder : pg8::StaticOrder {
    bool lat_only;
    __device__ __forceinline__ void init(int M, int N, int G_, int c_, bool lo) { lat_only = lo; pg8::StaticOrder::init(lo ? M - 4 * 256 : M, N, G_, c_); }
    __device__ __forceinline__ bool next(int i, pg8::Unit& u) const { if (!pg8::StaticOrder::next(i, u)) return false; if (lat_only) u.pm += (u.pm >> 4) + 1; return true; }
};
struct EpiPlainDummy {
    static constexpr bool PERM = true, AFTER_DRAIN = false;
    u16* O; int ldc;
    __device__ __forceinline__ void operator()(const A4 (&acc)[2][2][4][2], const pg8::Unit& u, int wr, int wc, int fr, int fq) const {
#pragma unroll
        for (int ai = 0; ai < 2; ++ai)
#pragma unroll
            for (int m = 0; m < 4; ++m) { const int row = u.pm * 256 + ai * 128 + wr * 64 + m * 16 + fr;
#pragma unroll
                for (int bj = 0; bj < 2; ++bj) { const A4 v0 = acc[ai][bj][m][0], v1 = acc[ai][bj][m][1]; const int col = (u.pn % 11) * 256 + bj * 128 + wc * 32 + fq * 8;
                    pg8::u32x4 w; w.x = pg8::cvt_pk_bf16(v0[0], v0[1]); w.y = pg8::cvt_pk_bf16(v0[2], v0[3]); w.z = pg8::cvt_pk_bf16(v1[0], v1[1]); w.w = pg8::cvt_pk_bf16(v1[2], v1[3]);
                    *(pg8::u32x4*)(O + (size_t)row * ldc + col) = w; } }
    }
};
__device__ PHASE_INLINE void sc1_phase(KP p, int l, unsigned char* smem, int* qslot) {
    const int G = OG();
    const u16* Pb = (const u16*)(p->ws + WS_PB); const u16* LF = (const u16*)(p->ws + WS_LF);
    u16* SB = (u16*)(p->ws + WS_SB); float* SA = (float*)(p->ws + WS_SA); u16* RB = (u16*)(p->ws + WS_RB); float* E = (float*)(p->ws + WS_E);
    constexpr int N_HG = 1088, N_RT = 1088, N_S5 = 1088;
    { const int tid = opaque_tid(), lane = tid & 63, wave = tid >> 6, q4 = lane >> 4, r16 = lane & 15;
      WQ wq; wq.init((unsigned*)(p->ws + WS_CTL) + CW_Q + l * 128 + 32, qslot + 4, true, OB(), G, tid);
      for (int it = wq.first(tid); it < N_HG; it = wq.next(tid)) { wq.prefetch(tid);
            const int b = it / 272, c = (it % 272) >> 2, h = it & 3, R0 = b * TPB + c * 64;
            float* tot = (float*)smem;
            u16* vs = (u16*)(smem + 8192);
            u16* kt = (u16*)(smem + 25600);
            const int tok0 = wave * 8;
            float2 lf[2][8], ex[2][8];
#pragma unroll
            for (int tt = 0; tt < 8; ++tt) { const size_t row = (size_t)(R0 + tok0 + tt);
                lf[0][tt] = ldh2(LF + row * 1024 + h * 128 + 2 * lane); lf[1][tt] = ldh2(LF + row * 1024 + 512 + h * 128 + 2 * lane); }
#pragma unroll
            for (int i = 0; i < 2; ++i) { const int idx = tid + 512 * i, tok = idx >> 4, sg = idx & 15;
                *(pg8::u32x4*)(vs + tok * 136 + sg * 8) = *(const pg8::u32x4*)(Pb + (size_t)(R0 + tok) * PBC + 512 + h * 128 + sg * 8); }
            { float2 s0 = make_float2(0.f, 0.f), s1 = s0;
#pragma unroll
              for (int tt = 7; tt >= 0; --tt) { ex[0][tt] = s0; s0.x += lf[0][tt].x; s0.y += lf[0][tt].y; }
#pragma unroll
              for (int tt = 0; tt < 8; ++tt) { ex[1][tt] = s1; s1.x += lf[1][tt].x; s1.y += lf[1][tt].y; }
              *(float2*)(tot + wave * 128 + 2 * lane) = s0; *(float2*)(tot + (8 + wave) * 128 + 2 * lane) = s1; }
            __syncthreads();
            { float2 o0 = make_float2(0.f, 0.f), o1 = o0, a0 = o0, a1 = o0;
#pragma unroll
              for (int k = 0; k < 8; ++k) { const float2 t0 = *(const float2*)(tot + k * 128 + 2 * lane), t1 = *(const float2*)(tot + (8 + k) * 128 + 2 * lane);
                  if (k > wave) { o0.x += t0.x; o0.y += t0.y; } if (k < wave) { o1.x += t1.x; o1.y += t1.y; } a0.x += t0.x; a0.y += t0.y; a1.x += t1.x; a1.y += t1.y; }
              if (wave == 0) { *(float2*)(SA + ((size_t)((b * 4 + h) * 2 + 0) * NCH + c) * 128 + 2 * lane) = make_float2(__expf(a0.x), __expf(a0.y));
                               *(float2*)(SA + ((size_t)((b * 4 + h) * 2 + 1) * NCH + c) * 128 + 2 * lane) = make_float2(__expf(a1.x), __expf(a1.y)); }
#pragma unroll
              for (int tt = 0; tt < 8; ++tt) { const int tok = tok0 + tt;
                  *(unsigned*)(kt + tok * 136 + 2 * lane) = pk2((1.f - __expf(lf[0][tt].x)) * __expf(ex[0][tt].x + o0.x), (1.f - __expf(lf[0][tt].y)) * __expf(ex[0][tt].y + o0.y));
                  *(unsigned*)(kt + (64 + tok) * 136 + 2 * lane) = pk2((1.f - __expf(lf[1][tt].x)) * __expf(ex[1][tt].x + o1.x), (1.f - __expf(lf[1][tt].y)) * __expf(ex[1][tt].y + o1.y)); } }
            __syncthreads();
#pragma unroll
            for (int rep = 0; rep < 2; ++rep) { const int pr = wave + 8 * rep, d = pr >> 3, mt = pr & 7;
                const v8s a0 = trfrag((const unsigned char*)(kt + d * 64 * 136), 272, 16 * mt, 0, lane), a1 = trfrag((const unsigned char*)(kt + d * 64 * 136), 272, 16 * mt, 32, lane);
                u16* dst = SB + ((size_t)((b * 4 + h) * 2 + d) * NCH + c) * 16384 + 16 * mt + 4 * q4;
#pragma unroll 2
                for (int nt = 0; nt < 8; ++nt) { v4f acc = {0.f, 0.f, 0.f, 0.f};
                    acc = mma16(a0, trfrag((const unsigned char*)vs, 272, 16 * nt, 0, lane), acc); acc = mma16(a1, trfrag((const unsigned char*)vs, 272, 16 * nt, 32, lane), acc);
                    v2u w; w.x = pk2(acc[0], acc[1]); w.y = pk2(acc[2], acc[3]); *(v2u*)(dst + (16 * nt + r16) * 128) = w; } }
            __syncthreads();
      } }
    { const int tid = opaque_tid(), lane = tid & 63, wave = tid >> 6, q4 = lane >> 4, r16 = lane & 15;
      WQ wq; wq.init((unsigned*)(p->ws + WS_CTL) + CW_Q + l * 128 + 96, qslot + 6, true, (OB() + G - 64 % G) % G, G, tid);
      for (int it = wq.first(tid); it < N_RT; it = wq.next(tid)) { wq.prefetch(tid);
            const int b = it / 272, c = (it % 272) >> 2, h = it & 3, R0 = b * TPB + c * 64;
            u16* kt = (u16*)smem;
            u16* vs = kt + 2 * 64 * 72;
            const float rf = p->in[9][l * 8 + h], rb = p->in[9][l * 8 + 4 + h];
            const float lgf = -__logf(1.f + __expf(-rf)), lgb = -__logf(1.f + __expf(-rb));
            { const int tok = tid >> 3, sg = tid & 7;
              const pg8::u32x4 kw = *(const pg8::u32x4*)(Pb + (size_t)(R0 + tok) * PBC + 1792 + h * 64 + sg * 8);
              *(pg8::u32x4*)(vs + tok * 72 + sg * 8) = *(const pg8::u32x4*)(Pb + (size_t)(R0 + tok) * PBC + 2048 + h * 64 + sg * 8);
              const float df = __expf(lgf * (float)(63 - tok)), db = __expf(lgb * (float)tok);
              const unsigned kk[4] = {kw.x, kw.y, kw.z, kw.w}; unsigned f4[4], b4[4];
#pragma unroll
              for (int j = 0; j < 4; ++j) { const float k0 = __uint_as_float(kk[j] << 16), k1 = __uint_as_float(kk[j] & 0xffff0000u); f4[j] = pk2(k0 * df, k1 * df); b4[j] = pk2(k0 * db, k1 * db); }
              pg8::u32x4 wf; wf.x = f4[0]; wf.y = f4[1]; wf.z = f4[2]; wf.w = f4[3]; pg8::u32x4 wb; wb.x = b4[0]; wb.y = b4[1]; wb.z = b4[2]; wb.w = b4[3];
              *(pg8::u32x4*)(kt + tok * 72 + sg * 8) = wf; *(pg8::u32x4*)(kt + (64 + tok) * 72 + sg * 8) = wb; }
            __syncthreads();
#pragma unroll
            for (int i = 0; i < 4; ++i) { const int tt = wave + 8 * i, d = tt >> 4, mt = (tt >> 2) & 3, nt = tt & 3;
                v4f acc = {0.f, 0.f, 0.f, 0.f};
#pragma unroll
                for (int ks = 0; ks < 2; ++ks) acc = mma16(trfrag((const unsigned char*)(kt + d * 64 * 72), 144, 16 * mt, 32 * ks, lane), trfrag((const unsigned char*)vs, 144, 16 * nt, 32 * ks, lane), acc);
                v2u w; w.x = pk2(acc[0], acc[1]); w.y = pk2(acc[2], acc[3]);
                *(v2u*)(RB + ((size_t)((b * 4 + h) * 2 + d) * NCH + c) * 4096 + (16 * nt + r16) * 64 + 16 * mt + 4 * q4) = w; }
            __syncthreads();
      } }
    { const int tid = opaque_tid(), lane = tid & 63, wave = tid >> 6, q4 = lane >> 4, r16 = lane & 15; (void)tid;
      for (int it = (OB() + G - 128 % G) % G; it < 256; it += G) {
            const int g = it & 15, grp = it >> 4, rt0 = grp * 4 + (grp < 4 ? grp : 4), nrt = 4 + (grp < 4 ? 1 : 0);
            v8s bw[2][8];
#pragma unroll
            for (int d = 0; d < 2; ++d) { const u16* bt = (const u16*)(p->ws + WS_BTE) + ((size_t)((l * 2 + d) * 16 + g) * 128 + 16 * wave + r16) * 256 + 8 * q4;
#pragma unroll
                for (int ks = 0; ks < 8; ++ks) bw[d][ks] = *(const v8s*)(bt + 32 * ks); }
            for (int k = 0; k < nrt; ++k) { const int rt = rt0 + k, b = rt / 17, sc = rt - b * 17, R0 = b * TPB + sc * 256;
                v8s a[8];
#pragma unroll
                for (int ks = 0; ks < 8; ++ks) a[ks] = *(const v8s*)(Pb + (size_t)(R0 + r16 * 16 + 2 * ks + (q4 >> 1)) * PBC + 2560 + g * 16 + 8 * (q4 & 1));
#pragma unroll
                for (int d = 0; d < 2; ++d) { v4f acc = {0.f, 0.f, 0.f, 0.f};
#pragma unroll
                    for (int ks = 0; ks < 8; ++ks) acc = mma16(a[ks], bw[d][ks], acc);
                    float* ep = E + ((size_t)((b * 16 + g) * 2 + d) * NBLK + sc * 16 + 4 * q4) * 128 + 16 * wave + r16;
#pragma unroll
                    for (int e = 0; e < 4; ++e) ep[(size_t)e * 128] = acc[e]; } }
      } }
}

__device__ PHASE_INLINE void sc2_phase(KP p, int l, unsigned char* smem) {
    const int G = OG();
    u16* SB = (u16*)(p->ws + WS_SB); const float* SA = (const float*)(p->ws + WS_SA); u16* RB = (u16*)(p->ws + WS_RB); const float* E = (const float*)(p->ws + WS_E); u16* HS = (u16*)(p->ws + WS_HS);
    constexpr int N_S5 = 128, N_HG = 256, N_RT = 64;
    { const int tid = opaque_tid();
      for (int it = OB(); it < N_S5; it += G) {
            { const int b = it >> 5, g = (it >> 1) & 15, d = it & 1;
              float2* tot = (float2*)smem;
              float2* st0 = tot + 17 * 64;
              const float* eb = E + (size_t)((b * 16 + g) * 2 + d) * NBLK * 128; u16* hb = HS + (size_t)((b * 16 + g) * 2 + d) * NBLK * 128;
              for (int w0 = 0; w0 < 3; ++w0) {
                  const int pr = tid + 512 * w0, pp = pr & 63, seg = pr >> 6;
                  if (seg < 17) { const float2 a1 = ((const float2*)(p->ws + WS_TAB + TAB_A16))[((l * 2 + d) * 16 + g) * 64 + pp];
                      float er[16], ei[16];
#pragma unroll
                      for (int j = 0; j < 16; ++j) { const int s = seg * 16 + j, blk = d ? (s < 16 ? 15 - s : 287 - s) : s; er[j] = eb[(size_t)blk * 128 + pp]; ei[j] = eb[(size_t)blk * 128 + 64 + pp]; }
                      float hr = 0.f, hi = 0.f;
#pragma unroll
                      for (int j = 0; j < 16; ++j) { const float nr = a1.x * hr - a1.y * hi + er[j], ni = a1.x * hi + a1.y * hr + ei[j]; hr = nr; hi = ni; }
                      tot[seg * 64 + pp] = make_float2(hr, hi); } }
              __syncthreads();
              if (tid < 64) { const int pp = tid; const float2 a1 = ((const float2*)(p->ws + WS_TAB + TAB_A16))[((l * 2 + d) * 16 + g) * 64 + pp];
                  float2 a256 = a1;
#pragma unroll
                  for (int k = 0; k < 4; ++k) a256 = make_float2(a256.x * a256.x - a256.y * a256.y, 2.f * a256.x * a256.y);
                  float hr = 0.f, hi = 0.f;
                  for (int seg = 0; seg < 17; ++seg) { st0[seg * 64 + pp] = make_float2(hr, hi); const float2 t = tot[seg * 64 + pp];
                      const float nr = a256.x * hr - a256.y * hi + t.x, ni = a256.x * hi + a256.y * hr + t.y; hr = nr; hi = ni; } }
              __syncthreads();
              for (int w0 = 0; w0 < 3; ++w0) {
                  const int pr = tid + 512 * w0, pp = pr & 63, seg = pr >> 6;
                  if (seg < 17) { const float2 a1 = ((const float2*)(p->ws + WS_TAB + TAB_A16))[((l * 2 + d) * 16 + g) * 64 + pp];
                      float er[16], ei[16];
#pragma unroll
                      for (int j = 0; j < 16; ++j) { const int s = seg * 16 + j, blk = d ? (s < 16 ? 15 - s : 287 - s) : s; er[j] = eb[(size_t)blk * 128 + pp]; ei[j] = eb[(size_t)blk * 128 + 64 + pp]; }
                      const float2 h0 = st0[seg * 64 + pp]; float hr = h0.x, hi = h0.y;
#pragma unroll
                      for (int j = 0; j < 16; ++j) { const int s = seg * 16 + j, blk = d ? (s < 16 ? 15 - s : 287 - s) : s;
                          hb[(size_t)blk * 128 + pp] = f2bf(hr); hb[(size_t)blk * 128 + 64 + pp] = f2bf(hi);
                          const float nr = a1.x * hr - a1.y * hi + er[j], ni = a1.x * hi + a1.y * hr + ei[j]; hr = nr; hi = ni; } } }
              __syncthreads(); }
      } }
    { const int tid = opaque_tid();
      for (int it = (OB() + G - 128 % G) % G; it < N_HG; it += G) {
            const int gid = it * 512 + tid, chain = gid >> 12, e4 = (gid & 4095) * 4, dk = e4 & 127, d = chain & 1;
            u16* sb = SB + (size_t)chain * NCH * 16384 + e4; const float* sa = SA + (size_t)chain * NCH * 128 + dk;
            float S0 = 0.f, S1 = 0.f, S2 = 0.f, S3 = 0.f;
            for (int s0 = 0; s0 < NCH; s0 += 17) { v2u bv[17]; v4f av[17];
#pragma unroll
                for (int j = 0; j < 17; ++j) { const int s = s0 + j, c = d ? (s < 4 ? 3 - s : 71 - s) : s; bv[j] = *(const v2u*)(sb + (size_t)c * 16384); av[j] = *(const v4f*)(sa + (size_t)c * 128); }
#pragma unroll
                for (int j = 0; j < 17; ++j) { const int s = s0 + j, c = d ? (s < 4 ? 3 - s : 71 - s) : s;
                    v2u w; w.x = pk2(S0, S1); w.y = pk2(S2, S3); *(v2u*)(sb + (size_t)c * 16384) = w;
                    S0 = av[j][0] * S0 + __uint_as_float(bv[j].x << 16); S1 = av[j][1] * S1 + __uint_as_float(bv[j].x & 0xffff0000u);
                    S2 = av[j][2] * S2 + __uint_as_float(bv[j].y << 16); S3 = av[j][3] * S3 + __uint_as_float(bv[j].y & 0xffff0000u); } }
      } }
    { const int tid = opaque_tid();
      for (int it = (OB() + G - 128 % G) % G; it < N_RT; it += G) {
            const int gid = it * 512 + tid, chain = gid >> 10, e4 = (gid & 1023) * 4, d = chain & 1, h = (chain >> 1) & 3;
            const float raw = p->in[9][l * 8 + d * 4 + h]; const float a = __expf(-64.f * __logf(1.f + __expf(-raw)));
            u16* rb = RB + (size_t)chain * NCH * 4096 + e4;
            float S0 = 0.f, S1 = 0.f, S2 = 0.f, S3 = 0.f;
            for (int s0 = 0; s0 < NCH; s0 += 17) { v2u bv[17];
#pragma unroll
                for (int j = 0; j < 17; ++j) { const int s = s0 + j, c = d ? (s < 4 ? 3 - s : 71 - s) : s; bv[j] = *(const v2u*)(rb + (size_t)c * 4096); }
#pragma unroll
                for (int j = 0; j < 17; ++j) { const int s = s0 + j, c = d ? (s < 4 ? 3 - s : 71 - s) : s;
                    v2u w; w.x = pk2(S0, S1); w.y = pk2(S2, S3); *(v2u*)(rb + (size_t)c * 4096) = w;
                    S0 = a * S0 + __uint_as_float(bv[j].x << 16); S1 = a * S1 + __uint_as_float(bv[j].x & 0xffff0000u);
                    S2 = a * S2 + __uint_as_float(bv[j].y << 16); S3 = a * S3 + __uint_as_float(bv[j].y & 0xffff0000u); } }
      } }
}
template <int SUBMASK = 7, bool QUEUE = true> __device__ PHASE_INLINE void sc3_phase(KP p, int l, unsigned char* smem, int* qslot, int qbase) {
    const int G = OG();
    const u16* Pb = (const u16*)(p->ws + WS_PB); const u16* LF = (const u16*)(p->ws + WS_LF);
    const u16* SB = (const u16*)(p->ws + WS_SB); const u16* RB = (const u16*)(p->ws + WS_RB); const u16* HS = (const u16*)(p->ws + WS_HS);
    u16* Mx = (u16*)(p->ws + WS_MX); u16* S5G = (u16*)(p->ws + WS_S5G);
    constexpr int N_HG = 1088, N_RT = 1088, N_S5 = 1088;
    if constexpr (SUBMASK & 1) { const int tid = opaque_tid(), lane = tid & 63, wave = tid >> 6, q4 = lane >> 4, r16 = lane & 15;
      WQ wq; wq.init((unsigned*)(p->ws + WS_CTL) + CW_Q + qbase, qslot, QUEUE, OB(), G, tid);
      for (int it = wq.first(tid); it < N_HG; it = wq.next(tid)) { wq.prefetch(tid);
            const int b = it / 272, c = (it % 272) >> 2, h = it & 3, R0 = b * TPB + c * 64, chain0 = (b * 4 + h) * 2;
            float* tot = (float*)smem;
            u16* vs = (u16*)(smem + 8192);
            u16* qJ = (u16*)(smem + 25600);
            u16* kb = (u16*)(smem + 69120);
            u16* Pm = (u16*)(smem + 86528);
            float* ssq = (float*)(smem + 95744);
            u16* obuf = (u16*)(smem + 97792);
            const int tok0 = wave * 8, tbme = wave >> 1;
            unsigned qw[8]; float2 lf[2][8], cc[2][8];
#pragma unroll
            for (int tt = 0; tt < 8; ++tt) { const size_t row = (size_t)(R0 + tok0 + tt);
                qw[tt] = *(const unsigned*)(Pb + row * PBC + h * 128 + 2 * lane);
                lf[0][tt] = ldh2(LF + row * 1024 + h * 128 + 2 * lane); lf[1][tt] = ldh2(LF + row * 1024 + 512 + h * 128 + 2 * lane); }
#pragma unroll
            for (int i = 0; i < 2; ++i) { const int idx = tid + 512 * i, tok = idx >> 4, sg = idx & 15;
                *(pg8::u32x4*)(vs + tok * 136 + sg * 8) = *(const pg8::u32x4*)(Pb + (size_t)(R0 + tok) * PBC + 512 + h * 128 + sg * 8); }
            v8s bfr[2][4];
#pragma unroll
            for (int d = 0; d < 2; ++d)
#pragma unroll
                for (int ks = 0; ks < 4; ++ks) bfr[d][ks] = *(const v8s*)(SB + ((size_t)(chain0 + d) * NCH + c) * 16384 + (16 * wave + r16) * 128 + 32 * ks + 8 * q4);
            { float2 r0 = make_float2(0.f, 0.f), r1 = make_float2(0.f, 0.f);
#pragma unroll
              for (int tt = 0; tt < 8; ++tt) { r0.x += lf[0][tt].x; r0.y += lf[0][tt].y; cc[0][tt] = r0; }
#pragma unroll
              for (int tt = 7; tt >= 0; --tt) { r1.x += lf[1][tt].x; r1.y += lf[1][tt].y; cc[1][tt] = r1; }
              *(float2*)(tot + (0 * 8 + wave) * 128 + 2 * lane) = r0; *(float2*)(tot + (8 + wave) * 128 + 2 * lane) = r1; }
            __syncthreads();
            float2 cj[2][4], cjm[2];
            { float2 run = make_float2(0.f, 0.f), off = run;
#pragma unroll
              for (int k = 0; k < 8; ++k) { if (k == 0) cj[0][0] = run; if (k == 2) cj[0][1] = run; if (k == 4) cj[0][2] = run; if (k == 6) cj[0][3] = run; if (k == wave) off = run; if (k == 2 * tbme) cjm[0] = run;
                  const float2 t = *(const float2*)(tot + k * 128 + 2 * lane); run.x += t.x; run.y += t.y; }
#pragma unroll
              for (int tt = 0; tt < 8; ++tt) { cc[0][tt].x += off.x; cc[0][tt].y += off.y; }
              run = make_float2(0.f, 0.f); off = run;
#pragma unroll
              for (int k = 7; k >= 0; --k) { if (k == 7) cj[1][3] = run; if (k == 5) cj[1][2] = run; if (k == 3) cj[1][1] = run; if (k == 1) cj[1][0] = run; if (k == wave) off = run; if (k == 2 * tbme + 1) cjm[1] = run;
                  const float2 t = *(const float2*)(tot + (8 + k) * 128 + 2 * lane); run.x += t.x; run.y += t.y; }
#pragma unroll
              for (int tt = 0; tt < 8; ++tt) { cc[1][tt].x += off.x; cc[1][tt].y += off.y; } }
            v4f acc[4];
#pragma unroll
            for (int mt = 0; mt < 4; ++mt) acc[mt] = (v4f){0.f, 0.f, 0.f, 0.f};
#pragma unroll
            for (int d = 0; d < 2; ++d) {
                { const float2 cjme = cjm[d];
#pragma unroll
                  for (int tt = 0; tt < 8; ++tt) { const int tok = tok0 + tt; const float q0 = __uint_as_float(qw[tt] << 16), q1 = __uint_as_float(qw[tt] & 0xffff0000u);
                      const float2 cx = cc[d][tt], lv = lf[d][tt];
                      *(unsigned*)(kb + tok * 136 + 2 * lane) = pk2((1.f - __expf(lv.x)) * __expf(fminf(cjme.x - cx.x, 60.f)), (1.f - __expf(lv.y)) * __expf(fminf(cjme.y - cx.y, 60.f)));
#pragma unroll
                      for (int TB = 0; TB < 4; ++TB) { const bool valid = d ? (tbme <= TB) : (tbme >= TB);
                          if (valid) { const int offf = 8 * TB * (9 - TB), offb = 8 * (3 - TB) * (6 + TB); const int rowq = d ? (offb + tok) : (offf + tok - 16 * TB);
                              *(unsigned*)(qJ + rowq * 136 + 2 * lane) = pk2(q0 * __expf(fminf(cx.x - cj[d][TB].x, 0.f)), q1 * __expf(fminf(cx.y - cj[d][TB].y, 0.f))); } } } }
                __syncthreads();
#pragma unroll
                for (int mt = 0; mt < 4; ++mt)
#pragma unroll
                    for (int ks = 0; ks < 4; ++ks) acc[mt] = mma16(ldfrag(qJ, 136, 16 * mt, 32 * ks, lane), bfr[d][ks], acc[mt]);
#pragma unroll
                for (int rep = 0; rep < 2; ++rep) { const int u = wave + 8 * rep;
                    if (u < 10) { const int tbf = (int)((0x3221110000ull >> (4 * u)) & 15ull), mtf = (int)((0x3323213210ull >> (4 * u)) & 15ull);
                        const int TB = d ? 3 - tbf : tbf, mt = d ? 3 - mtf : mtf;
                        const int offf = 8 * TB * (9 - TB), offb = 8 * (3 - TB) * (6 + TB); const int rowbase = d ? (offb + 16 * mt) : (offf + 16 * (mt - TB));
                        v4f pa = {0.f, 0.f, 0.f, 0.f};
#pragma unroll
                        for (int ks = 0; ks < 4; ++ks) pa = mma16(ldfrag(kb, 136, 16 * TB, 32 * ks, lane), ldfrag(qJ, 136, rowbase, 32 * ks, lane), pa);
                        const int ti = 16 * mt + r16, tj0 = 16 * TB + 4 * q4; float pv[4];
#pragma unroll
                        for (int e = 0; e < 4; ++e) { const int tj = tj0 + e; const bool keep = d ? (tj >= ti) : (tj <= ti); pv[e] = keep ? pa[e] : 0.f; }
                        v2u w; w.x = pk2(pv[0], pv[1]); w.y = pk2(pv[2], pv[3]); *(v2u*)(Pm + ti * 72 + tj0) = w; } }
                if (wave >= 2) { const int z = wave - 2; const int zm = (int)((0x211000u >> (4 * z)) & 15u), zt = (int)((0x332321u >> (4 * z)) & 15u);
                    const int mt = d ? 3 - zm : zm, TB = d ? 3 - zt : zt; v2u w; w.x = 0u; w.y = 0u; *(v2u*)(Pm + (16 * mt + r16) * 72 + 16 * TB + 4 * q4) = w; }
                __syncthreads();
#pragma unroll
                for (int mt = 0; mt < 4; ++mt)
#pragma unroll
                    for (int ks = 0; ks < 2; ++ks) acc[mt] = mma16(ldfrag(Pm, 72, 16 * mt, 32 * ks, lane), trfrag((const unsigned char*)vs, 272, 16 * wave, 32 * ks, lane), acc[mt]);
            }
#pragma unroll
            for (int mt = 0; mt < 4; ++mt)
#pragma unroll
                for (int e = 0; e < 4; ++e) { float s = acc[mt][e] * acc[mt][e]; s += shx(s, 1, lane); s += shx(s, 2, lane); s += shx(s, 4, lane); s += shx(s, 8, lane);
                    if (r16 == 0) ssq[wave * 64 + 16 * mt + 4 * q4 + e] = s; }
            __syncthreads();
            { const int vc = 16 * wave + r16; const float gn = p->in[8][l * 128 + vc];
#pragma unroll
              for (int mt = 0; mt < 4; ++mt)
#pragma unroll
                  for (int e = 0; e < 4; ++e) { const int tok = 16 * mt + 4 * q4 + e; float tt = 0.f;
#pragma unroll
                      for (int w = 0; w < 8; ++w) tt += ssq[w * 64 + tok];
                      obuf[tok * 136 + vc] = f2bf(acc[mt][e] * rsqrtf(tt * (1.f / 128.f) + LN_EPS_F) * gn); } }
            __syncthreads();
#pragma unroll
            for (int i = 0; i < 2; ++i) { const int idx = tid + 512 * i, tok = idx >> 4, sg = idx & 15;
                const pg8::u32x4 o8 = *(const pg8::u32x4*)(obuf + tok * 136 + sg * 8), g8 = *(const pg8::u32x4*)(Pb + (size_t)(R0 + tok) * PBC + 1024 + h * 128 + sg * 8);
                const unsigned oo[4] = {o8.x, o8.y, o8.z, o8.w}, gg[4] = {g8.x, g8.y, g8.z, g8.w}; unsigned rr[4];
#pragma unroll
                for (int j = 0; j < 4; ++j) rr[j] = pk2(__uint_as_float(oo[j] << 16) * __uint_as_float(gg[j] << 16), __uint_as_float(oo[j] & 0xffff0000u) * __uint_as_float(gg[j] & 0xffff0000u));
                pg8::u32x4 w; w.x = rr[0]; w.y = rr[1]; w.z = rr[2]; w.w = rr[3];
                *(pg8::u32x4*)(Mx + (size_t)(R0 + tok) * 1024 + h * 128 + sg * 8) = w; }
            __syncthreads();
      } }
    if constexpr (SUBMASK & 2) { const int tid = opaque_tid(), lane = tid & 63, wave = tid >> 6, q4 = lane >> 4, r16 = lane & 15;
      WQ wq; wq.init((unsigned*)(p->ws + WS_CTL) + CW_Q + qbase + 64, qslot + 2, QUEUE, (OB() + G - 64 % G) % G, G, tid);
      for (int it = wq.first(tid); it < N_RT; it = wq.next(tid)) { wq.prefetch(tid);
            const int b = it / 272, c = (it % 272) >> 2, h = it & 3, R0 = b * TPB + c * 64;
            u16* qs = (u16*)smem;
            u16* ks_ = qs + 64 * 72;
            u16* vs = ks_ + 64 * 72;
            u16* qd = vs + 64 * 72;
            u16* Pm = qd + 64 * 136;
            float* red = (float*)(Pm + 64 * 72);
            {
                const float rf = p->in[9][l * 8 + h], rb = p->in[9][l * 8 + 4 + h];
                const float lgf = -__logf(1.f + __expf(-rf)), lgb = -__logf(1.f + __expf(-rb));
                const int chain0 = (b * 4 + h) * 2;
                { const int tok = tid >> 3, seg = tid & 7;
                  const pg8::u32x4 qw = *(const pg8::u32x4*)(Pb + (size_t)(R0 + tok) * PBC + 1536 + h * 64 + seg * 8);
                  const pg8::u32x4 kw = *(const pg8::u32x4*)(Pb + (size_t)(R0 + tok) * PBC + 1792 + h * 64 + seg * 8);
                  const pg8::u32x4 vw = *(const pg8::u32x4*)(Pb + (size_t)(R0 + tok) * PBC + 2048 + h * 64 + seg * 8);
                  *(pg8::u32x4*)(qs + tok * 72 + seg * 8) = qw; *(pg8::u32x4*)(ks_ + tok * 72 + seg * 8) = kw; *(pg8::u32x4*)(vs + tok * 72 + seg * 8) = vw;
                  const float df = __expf(lgf * (float)(tok + 1)), db = __expf(lgb * (float)(64 - tok));
                  const unsigned qq[4] = {qw.x, qw.y, qw.z, qw.w};
#pragma unroll
                  for (int j = 0; j < 4; ++j) { const float q0 = __uint_as_float(qq[j] << 16), q1 = __uint_as_float(qq[j] & 0xffff0000u); const int ch = seg * 8 + 2 * j;
                      *(unsigned*)(qd + tok * 136 + ch) = pk2(q0 * df, q1 * df); *(unsigned*)(qd + tok * 136 + 64 + ch) = pk2(q0 * db, q1 * db); } }
                __syncthreads();
#pragma unroll
                for (int i = 0; i < 2; ++i) { const int tt = 2 * wave + i, mt = tt >> 2, nt = tt & 3; v4f pa = {0.f, 0.f, 0.f, 0.f};
#pragma unroll
                    for (int ks = 0; ks < 2; ++ks) pa = mma16(ldfrag(qs, 72, 16 * mt, 32 * ks, lane), ldfrag(ks_, 72, 16 * nt, 32 * ks, lane), pa);
#pragma unroll
                    for (int e = 0; e < 4; ++e) { const int ti = 16 * mt + 4 * q4 + e, tj = 16 * nt + r16;
                        const float D = (tj <= ti ? __expf(lgf * (float)(ti - tj)) : 0.f) + (tj >= ti ? __expf(lgb * (float)(tj - ti)) : 0.f);
                        Pm[ti * 72 + tj] = f2bf(pa[e] * D); } }
                __syncthreads();
                const int nt = wave & 3; v4f acc[2]; v8s bi[4];
#pragma unroll
                for (int d = 0; d < 2; ++d) { const u16* rbp = RB + ((size_t)(chain0 + d) * NCH + c) * 4096 + (16 * nt + r16) * 64 + 8 * q4;
                    bi[d * 2 + 0] = *(const v8s*)(rbp); bi[d * 2 + 1] = *(const v8s*)(rbp + 32); }
#pragma unroll
                for (int i = 0; i < 2; ++i) { const int mt = 2 * (wave >> 2) + i; v4f a = {0.f, 0.f, 0.f, 0.f};
#pragma unroll
                    for (int kk = 0; kk < 4; ++kk) a = mma16(ldfrag(qd, 136, 16 * mt, 32 * kk, lane), bi[kk], a);
#pragma unroll
                    for (int ks = 0; ks < 2; ++ks) a = mma16(ldfrag(Pm, 72, 16 * mt, 32 * ks, lane), trfrag((const unsigned char*)vs, 144, 16 * nt, 32 * ks, lane), a);
                    acc[i] = a; }
#pragma unroll
                for (int i = 0; i < 2; ++i)
#pragma unroll
                    for (int e = 0; e < 4; ++e) { const int tok = 16 * (2 * (wave >> 2) + i) + 4 * q4 + e; float s1 = acc[i][e], s2 = s1 * s1;
                        s1 += shx(s1, 1, lane); s2 += shx(s2, 1, lane); s1 += shx(s1, 2, lane); s2 += shx(s2, 2, lane); s1 += shx(s1, 4, lane); s2 += shx(s2, 4, lane); s1 += shx(s1, 8, lane); s2 += shx(s2, 8, lane);
                        if (r16 == 0) { red[(nt * 64 + tok) * 2] = s1; red[(nt * 64 + tok) * 2 + 1] = s2; } }
                __syncthreads();
                { const int vc = 16 * nt + r16; const float gg = p->in[10][l * 256 + h * 64 + vc], gb = p->in[11][l * 256 + h * 64 + vc];
#pragma unroll
                  for (int i = 0; i < 2; ++i)
#pragma unroll
                      for (int e = 0; e < 4; ++e) { const int tok = 16 * (2 * (wave >> 2) + i) + 4 * q4 + e; float s1 = 0.f, s2 = 0.f;
#pragma unroll
                          for (int w = 0; w < 4; ++w) { s1 += red[(w * 64 + tok) * 2]; s2 += red[(w * 64 + tok) * 2 + 1]; }
                          const float mean = s1 * (1.f / 64.f), var = fmaxf(s2 * (1.f / 64.f) - mean * mean, 0.f), rstd = rsqrtf(var + LN_EPS_F);
                          const float sg = bf2f(Pb[(size_t)(R0 + tok) * PBC + 2304 + h * 64 + vc]);
                          Mx[(size_t)(R0 + tok) * 1024 + 512 + h * 64 + vc] = f2bf(((acc[i][e] - mean) * rstd * gg + gb) * sg); } }
                __syncthreads();
            }
      } }
    if constexpr (SUBMASK & 4) { const int tid = opaque_tid(), lane = tid & 63, wave = tid >> 6, q4 = lane >> 4, r16 = lane & 15; (void)tid;
      for (int it = OB(); it < 256; it += G) {
            const int g = it & 15, grp = it >> 4, rt0 = grp * 4 + (grp < 4 ? grp : 4), nrt = 4 + (grp < 4 ? 1 : 0);
            v8s bw[2][16];
#pragma unroll
            for (int i = 0; i < 2; ++i) { const u16* bt = (const u16*)(p->ws + WS_BTY) + ((size_t)(l * 16 + g) * 256 + 16 * (2 * wave + i) + r16) * 512 + 8 * q4;
#pragma unroll
                for (int ks = 0; ks < 16; ++ks) bw[i][ks] = *(const v8s*)(bt + 32 * ks); }
            const int ch = g * 16 + r16; const float dd = p->in[19][l * 256 + ch];
            for (int k = 0; k < nrt; ++k) { const int rt = rt0 + k, b = rt / 17, sc = rt - b * 17, R0 = b * TPB + sc * 256;
                v8s a[16];
#pragma unroll
                for (int ks = 0; ks < 8; ++ks) a[ks] = *(const v8s*)(Pb + (size_t)(R0 + r16 * 16 + 2 * ks + (q4 >> 1)) * PBC + 2560 + g * 16 + 8 * (q4 & 1));
#pragma unroll
                for (int dq = 0; dq < 2; ++dq)
#pragma unroll
                    for (int ks = 0; ks < 4; ++ks) a[8 + dq * 4 + ks] = *(const v8s*)(HS + ((size_t)((b * 16 + g) * 2 + dq) * NBLK + sc * 16 + r16) * 128 + 32 * ks + 8 * q4);
#pragma unroll
                for (int i = 0; i < 2; ++i) { const int nt = 2 * wave + i; v4f acc = {0.f, 0.f, 0.f, 0.f};
#pragma unroll
                    for (int ks = 0; ks < 16; ++ks) acc = mma16(a[ks], bw[i][ks], acc);
#pragma unroll
                    for (int e = 0; e < 4; ++e) { const int row = R0 + (4 * q4 + e) * 16 + nt; const float uv = bf2f(Pb[(size_t)row * PBC + 2560 + ch]);
                        S5G[(size_t)row * 256 + ch] = f2bf(gelu_tanh(acc[e] + dd * uv)); } } }
      } }
}

__device__ __forceinline__ void ln_rows(v4f (&v)[4], const float* g, const float* bta, int lane) {
    float s = 0.f;
#pragma unroll
    for (int j = 0; j < 4; ++j) s += (v[j][0] + v[j][1]) + (v[j][2] + v[j][3]);
    const float mean = wave_sum(s, lane) * (1.f / 1024.f); float q = 0.f;
#pragma unroll
    for (int j = 0; j < 4; ++j) { const v4f d = v[j] - mean; q += (d[0] * d[0] + d[1] * d[1]) + (d[2] * d[2] + d[3] * d[3]); }
    const float rstd = rsqrtf(wave_sum(q, lane) * (1.f / 1024.f) + LN_EPS_F);
#pragma unroll
    for (int j = 0; j < 4; ++j) { const int col = 4 * lane + 256 * j; const v4f gg = *(const v4f*)(g + col), bb = *(const v4f*)(bta + col); v[j] = (v[j] - mean) * rstd * gg + bb; }
}

typedef _Float16 v8h __attribute__((ext_vector_type(8)));
template <bool DRY = false> __device__ PHASE_INLINE void ln1_phase(KP p, int l, unsigned char* smem) {
    const int tid = opaque_tid(), lane = tid & 63, wave = tid >> 6, G = OG(), RPW = (NTOK + G - 1) / G, q4 = lane >> 4, r16 = lane & 15;
    const u16* X = (const u16*)(p->ws + WS_X); u16* Xw = (u16*)(p->ws + (DRY ? WS_PB : WS_X)); u16* H = (u16*)(p->ws + (DRY ? WS_PB + 40 * MiB : WS_H));
    const float* MOD = (const float*)(p->ws + WS_TAB + TAB_MOD) + (size_t)l * 5 * 6144;
    int* tokE = (int*)(p->ws + WS_ROUTE + RT_TOKE); float* tokW = (float*)(p->ws + WS_ROUTE + RT_TOKW); int* tokP = (int*)(p->ws + WS_ROUTE + RT_TOKP);
    constexpr int WP = 1032;
    u16* Wh = (u16*)smem;
    u16* Ht = (u16*)(smem + 66048);
    float* part = (float*)(smem + 99072);
    float* lg = (float*)(smem + 115456);
    int* lcnt = (int*)(smem + 117504); int* gbase = lcnt + 16; int* recE = lcnt + 32; int* recP = recE + 512;
    { const u16* wrt = (const u16*)(p->ws + WS_TAB + TAB_WRT) + (size_t)l * 32 * 1024;
#pragma unroll
      for (int i = 0; i < 8; ++i) { const int pc = tid + 512 * i, o = pc >> 7, sg = pc & 127; *(pg8::u32x4*)(Wh + o * WP + sg * 8) = *(const pg8::u32x4*)(wrt + o * 1024 + sg * 8); } }
    if (tid < 16) lcnt[tid] = 0;
    __syncthreads();
    const float* lgm = p->in[23] + l * 1024; const float* lbt = p->in[24] + l * 1024;
    const bool last = (l == DEPTH - 1);
    const int nbatch = (RPW + 15) >> 4;
    v2u zr[2][4]; bool lv[2];
#define LN1_FETCH(BT) do { _Pragma("unroll") for (int s2 = 0; s2 < 2; ++s2) { const int i_ = (BT) * 16 + wave * 2 + s2, r_ = OB() * RPW + i_; \
        lv[s2] = (i_ < RPW) && (r_ < NTOK) && !(last && (r_ % TPB) < CTXL); \
        _Pragma("unroll") for (int j = 0; j < 4; ++j) { v2u z_; z_.x = 0u; z_.y = 0u; if (lv[s2]) z_ = *(const v2u*)(X + (size_t)r_ * DM + 4 * lane + 256 * j); zr[s2][j] = z_; } } } while (0)
    LN1_FETCH(0);
    for (int bt = 0; bt < nbatch; ++bt) {
        v4f v[2][4]; bool lvc[2];
#pragma unroll
        for (int s2 = 0; s2 < 2; ++s2) { lvc[s2] = lv[s2];
#pragma unroll
            for (int j = 0; j < 4; ++j) { const unsigned wx = zr[s2][j].x, wy = zr[s2][j].y; const h2_t ha = ash2(wx), hb = ash2(wy); v[s2][j] = (v4f){(float)ha[0], (float)ha[1], (float)hb[0], (float)hb[1]}; } }
        if (bt + 1 < nbatch) LN1_FETCH(bt + 1);
        {
          float s0 = 0.f, s1 = 0.f;
#pragma unroll
          for (int j = 0; j < 4; ++j) { s0 += (v[0][j][0] + v[0][j][1]) + (v[0][j][2] + v[0][j][3]); s1 += (v[1][j][0] + v[1][j][1]) + (v[1][j][2] + v[1][j][3]); }
#pragma unroll
          for (int o = 32; o >= 1; o >>= 1) { s0 += shx(s0, o, lane); s1 += shx(s1, o, lane); }
          const float m0 = s0 * (1.f / 1024.f), m1 = s1 * (1.f / 1024.f); float q0 = 0.f, q1 = 0.f;
#pragma unroll
          for (int j = 0; j < 4; ++j) { const v4f d0 = v[0][j] - m0, d1 = v[1][j] - m1; q0 += (d0[0] * d0[0] + d0[1] * d0[1]) + (d0[2] * d0[2] + d0[3] * d0[3]); q1 += (d1[0] * d1[0] + d1[1] * d1[1]) + (d1[2] * d1[2] + d1[3] * d1[3]); }
#pragma unroll
          for (int o = 32; o >= 1; o >>= 1) { q0 += shx(q0, o, lane); q1 += shx(q1, o, lane); }
          const float rs0 = rsqrtf(q0 * (1.f / 1024.f) + LN_EPS_F), rs1 = rsqrtf(q1 * (1.f / 1024.f) + LN_EPS_F);
#pragma unroll
          for (int j = 0; j < 4; ++j) { const int col = 4 * lane + 256 * j; const v4f gg = *(const v4f*)(lgm + col), bb = *(const v4f*)(lbt + col);
              v[0][j] = (v[0][j] - m0) * rs0 * gg + bb; v[1][j] = (v[1][j] - m1) * rs1 * gg + bb; } }
#pragma unroll
        for (int s2 = 0; s2 < 2; ++s2) { const int bi = wave * 2 + s2, i = bt * 16 + bi, r = OB() * RPW + i;
            if (lvc[s2]) { const int mi = mod_index(r); const float* md = MOD + (size_t)mi * 6144;
#pragma unroll
                for (int j = 0; j < 4; ++j) { const int col = 4 * lane + 256 * j; st4h(Xw + (size_t)r * DM + col, v[s2][j]);
                    const v4f sh = *(const v4f*)(md + 3072 + col), s2v = *(const v4f*)(md + 4096 + col); const v4f hv = v[s2][j] * (1.f + s2v) + sh;
                    v2u w; w.x = pk2(hv[0], hv[1]); w.y = pk2(hv[2], hv[3]); *(v2u*)(H + (size_t)r * DM + col) = w;
                    v2u hw; hw.x = pkh2(hv[0], hv[1]); hw.y = pkh2(hv[2], hv[3]); *(v2u*)(Ht + bi * WP + col) = hw; }
            } else {
#pragma unroll
                for (int j = 0; j < 4; ++j) { v2u z; z.x = 0u; z.y = 0u; *(v2u*)(Ht + bi * WP + 4 * lane + 256 * j) = z; }
            } }
        __syncthreads();
        { v4f a0 = {0.f, 0.f, 0.f, 0.f}, a1 = a0;
#pragma unroll
          for (int kk = 0; kk < 4; ++kk) { const int k0 = (wave * 4 + kk) * 32;
              const v8h af = *(const v8h*)(Ht + r16 * WP + k0 + 8 * q4), b0 = *(const v8h*)(Wh + r16 * WP + k0 + 8 * q4), b1 = *(const v8h*)(Wh + (16 + r16) * WP + k0 + 8 * q4);
              a0 = __builtin_amdgcn_mfma_f32_16x16x32_f16(af, b0, a0, 0, 0, 0); a1 = __builtin_amdgcn_mfma_f32_16x16x32_f16(af, b1, a1, 0, 0, 0); }
#pragma unroll
          for (int e = 0; e < 4; ++e) { part[(wave * 16 + 4 * q4 + e) * 32 + r16] = a0[e]; part[(wave * 16 + 4 * q4 + e) * 32 + 16 + r16] = a1[e]; } }
        __syncthreads();
        { float sacc = 0.f;
#pragma unroll
          for (int w = 0; w < 8; ++w) sacc += part[w * 512 + tid];
          lg[tid] = sacc; }
        __syncthreads();
        if (tid < 16) { const int bi = tid, i = bt * 16 + bi, r = OB() * RPW + i;
            const bool live = (i < RPW) && (r < NTOK) && !(last && (r % TPB) < CTXL);
            if (i < RPW) { if (!live) { recE[2 * i] = -1; recE[2 * i + 1] = -1; }
              else { const float* L = lg + bi * 32;
                const float* rgb = p->in[28] + l * 4;
                const float g0 = L[0] + rgb[0], g1 = L[1] + rgb[1], g2 = L[2] + rgb[2], g3 = L[3] + rgb[3];
                int gi = 0; float gm = g0;
                if (g1 > gm) { gm = g1; gi = 1; } if (g2 > gm) { gm = g2; gi = 2; } if (g3 > gm) { gm = g3; gi = 3; }
                const float gp = 1.f / (__expf(g0 - gm) + __expf(g1 - gm) + __expf(g2 - gm) + __expf(g3 - gm));
                const float* reb = p->in[30] + l * 16 + gi * 4; const float* Le = L + 4 + gi * 4;
                const float e0 = Le[0] + reb[0], e1 = Le[1] + reb[1], e2 = Le[2] + reb[2], e3 = Le[3] + reb[3];
                int i0 = 0; float m0 = e0;
                if (e1 > m0) { m0 = e1; i0 = 1; } if (e2 > m0) { m0 = e2; i0 = 2; } if (e3 > m0) { m0 = e3; i0 = 3; }
                int i1 = -1; float m1 = -3.0e38f;
                if (i0 != 0 && e0 > m1) { m1 = e0; i1 = 0; } if (i0 != 1 && e1 > m1) { m1 = e1; i1 = 1; } if (i0 != 2 && e2 > m1) { m1 = e2; i1 = 2; } if (i0 != 3 && e3 > m1) { m1 = e3; i1 = 3; }
                if (i1 < 0) { i1 = (i0 + 1) & 3; m1 = m0; }
                const float ex = __expf(m1 - m0), w0 = gp / (1.f + ex), w1 = gp * ex / (1.f + ex);
                const int E0 = gi * 4 + i0, E1 = gi * 4 + i1;
                if (!DRY) { const int lp0 = atomicAdd(&lcnt[E0], 1), lp1 = atomicAdd(&lcnt[E1], 1);
                    recE[2 * i] = E0; recE[2 * i + 1] = E1; recP[2 * i] = lp0; recP[2 * i + 1] = lp1;
                    tokE[2 * r] = E0; tokE[2 * r + 1] = E1; tokW[2 * r] = w0; tokW[2 * r + 1] = w1; }
                else if (w0 + w1 == -12345.f) recE[2 * i] = E0 + E1; } } }
    }
#undef LN1_FETCH
    __syncthreads();
    if (DRY) return;
    if (tid < 16) gbase[tid] = (int)__hip_atomic_fetch_add((unsigned*)(p->ws + WS_CTL) + CW_CNT + l * 16 + tid, (unsigned)lcnt[tid], __ATOMIC_RELAXED, __HIP_MEMORY_SCOPE_AGENT);
    __syncthreads();
    for (int i = tid; i < 2 * RPW; i += NTHREADS) { const int r = OB() * RPW + (i >> 1); if (r < NTOK && recE[i] >= 0) tokP[2 * r + (i & 1)] = gbase[recE[i]] + recP[i]; }
    __syncthreads();
}

__device__ __forceinline__ void moe_tables(KP p, int l, int* cntl, int* base, int* tileE, int* nT) {
    const int tid = opaque_tid();
    if (tid < 16) cntl[tid] = (int)__hip_atomic_load((unsigned*)(p->ws + WS_CTL) + CW_CNT + l * 16 + tid, __ATOMIC_RELAXED, __HIP_MEMORY_SCOPE_AGENT);
    __syncthreads();
    if (tid < 192) { int ts = 0, myE = -1;
#pragma unroll
        for (int e = 0; e < 16; ++e) { const int n = (cntl[e] + 255) >> 8; if (tid < 16 && e == tid) base[tid] = ts * 256; if (tid >= ts && tid < ts + n) myE = e; ts += n; }
        if (myE >= 0) tileE[tid] = myE;
        if (tid == 0) { base[16] = ts * 256; *nT = ts; } }
    __syncthreads();
}

__device__ PHASE_INLINE void gather_phase(KP p, int l, int* cntl, int* base, int* tileE, int* nT) {
    const int tid = opaque_tid(), lane = tid & 63, wave = tid >> 6, G = OG();
    moe_tables(p, l, cntl, base, tileE, nT);
    const u16* H = (const u16*)(p->ws + WS_H); u16* HSO = (u16*)(p->ws + WS_HSORT);
    const int* tokE = (const int*)(p->ws + WS_ROUTE + RT_TOKE); const float* tokW = (const float*)(p->ws + WS_ROUTE + RT_TOKW); const int* tokP = (const int*)(p->ws + WS_ROUTE + RT_TOKP);
    int* rinfo = (int*)(p->ws + WS_ROUTE + RT_RINFO); float* roww = (float*)(p->ws + WS_ROUTE + RT_ROWW);
    for (int r0 = (OB() * 8 + wave) * 4; r0 < NTOK; r0 += G * 32) {
        int rr[4][2]; bool ok[4];
#pragma unroll
        for (int k = 0; k < 4; ++k) { const int r = r0 + k; ok[k] = (r < NTOK) && !(l == DEPTH - 1 && (r % TPB) < CTXL);
            const int rs = ok[k] ? r : 0; const int e0 = tokE[2 * rs], e1 = tokE[2 * rs + 1], p0 = tokP[2 * rs], p1 = tokP[2 * rs + 1];
            rr[k][0] = min(max(base[e0 & 15] + p0, 0), MOEROWS - 1); rr[k][1] = min(max(base[e1 & 15] + p1, 0), MOEROWS - 1); }
        pg8::u32x4 ha[4], hb[4];
#pragma unroll
        for (int k = 0; k < 4; ++k) { const int rs = ok[k] ? r0 + k : 0; ha[k] = *(const pg8::u32x4*)(H + (size_t)rs * DM + lane * 16); hb[k] = *(const pg8::u32x4*)(H + (size_t)rs * DM + lane * 16 + 8); }
#pragma unroll
        for (int k = 0; k < 4; ++k) if (ok[k]) { const int r = r0 + k;
            *(pg8::u32x4*)(HSO + (size_t)rr[k][0] * DM + lane * 16) = ha[k]; *(pg8::u32x4*)(HSO + (size_t)rr[k][0] * DM + lane * 16 + 8) = hb[k];
            *(pg8::u32x4*)(HSO + (size_t)rr[k][1] * DM + lane * 16) = ha[k]; *(pg8::u32x4*)(HSO + (size_t)rr[k][1] * DM + lane * 16 + 8) = hb[k];
            if (lane == 0) { rinfo[rr[k][0]] = 2 * r; rinfo[rr[k][1]] = 2 * r + 1; roww[rr[k][0]] = tokW[2 * r]; roww[rr[k][1]] = tokW[2 * r + 1]; } }
    }
    for (int e = OB(); e < 16; e += G)
        for (int rr = base[e] + cntl[e] + tid; rr < base[e + 1]; rr += NTHREADS) { rinfo[rr] = -1; roww[rr] = 0.f; }
}

template <bool DRY = false> __device__ PHASE_INLINE void ln2_phase(KP p, int l) {
    const int tid = opaque_tid(), lane = tid & 63, wave = tid >> 6, G = OG();
    const u16* X = (const u16*)(p->ws + WS_X); u16* Xw = (u16*)(p->ws + (DRY ? WS_PB : WS_X)); u16* H = (u16*)(p->ws + (DRY ? WS_PB + 40 * MiB : WS_H)); const u16* Y2 = (const u16*)(p->ws + WS_Y2);
    const float* MOD = (const float*)(p->ws + WS_TAB + TAB_MOD) + (size_t)l * 5 * 6144;
    const float* lg = p->in[25] + l * 1024; const float* lb = p->in[26] + l * 1024;
    const bool last = (l == DEPTH - 1);
    for (int r0 = (OB() * 8 + wave) * 2; r0 < NTOK; r0 += G * 16) {
        v4f v[2][4]; bool ok[2]; const float* mdp[2];
#pragma unroll
        for (int s2 = 0; s2 < 2; ++s2) { const int r = r0 + s2, b = r / TPB, t = r - b * TPB; ok[s2] = (r < NTOK) && !(last && t < CTXL);
            const int rs = ok[s2] ? r : 0, bs = rs / TPB, ts = rs - bs * TPB; const float* md = MOD + (size_t)(ts < CTXL ? 4 : bs) * 6144; mdp[s2] = md;
#pragma unroll
            for (int j = 0; j < 4; ++j) { const int col = 4 * lane + 256 * j; const v4f x = ld4h(X + (size_t)rs * DM + col), g2 = *(const v4f*)(md + 5120 + col);
                const v2u ya = *(const v2u*)(Y2 + (size_t)rs * DM + col), yb = *(const v2u*)(Y2 + ((size_t)NTOK + rs) * DM + col);
                const v4f ys = {__uint_as_float(ya.x << 16) + __uint_as_float(yb.x << 16), __uint_as_float(ya.x & 0xffff0000u) + __uint_as_float(yb.x & 0xffff0000u), __uint_as_float(ya.y << 16) + __uint_as_float(yb.y << 16), __uint_as_float(ya.y & 0xffff0000u) + __uint_as_float(yb.y & 0xffff0000u)};
                v[s2][j] = x * ALPHA_F + g2 * ys; } }
        { float s0 = 0.f, s1 = 0.f;
#pragma unroll
          for (int j = 0; j < 4; ++j) { s0 += (v[0][j][0] + v[0][j][1]) + (v[0][j][2] + v[0][j][3]); s1 += (v[1][j][0] + v[1][j][1]) + (v[1][j][2] + v[1][j][3]); }
#pragma unroll
          for (int o = 32; o >= 1; o >>= 1) { s0 += shx(s0, o, lane); s1 += shx(s1, o, lane); }
          const float m0 = s0 * (1.f / 1024.f), m1 = s1 * (1.f / 1024.f); float q0 = 0.f, q1 = 0.f;
#pragma unroll
          for (int j = 0; j < 4; ++j) { const v4f d0 = v[0][j] - m0, d1 = v[1][j] - m1; q0 += (d0[0] * d0[0] + d0[1] * d0[1]) + (d0[2] * d0[2] + d0[3] * d0[3]); q1 += (d1[0] * d1[0] + d1[1] * d1[1]) + (d1[2] * d1[2] + d1[3] * d1[3]); }
#pragma unroll
          for (int o = 32; o >= 1; o >>= 1) { q0 += shx(q0, o, lane); q1 += shx(q1, o, lane); }
          const float rs0 = rsqrtf(q0 * (1.f / 1024.f) + LN_EPS_F), rs1 = rsqrtf(q1 * (1.f / 1024.f) + LN_EPS_F);
#pragma unroll
          for (int j = 0; j < 4; ++j) { const int col = 4 * lane + 256 * j; const v4f gg = *(const v4f*)(lg + col), bb = *(const v4f*)(lb + col);
              v[0][j] = (v[0][j] - m0) * rs0 * gg + bb; v[1][j] = (v[1][j] - m1) * rs1 * gg + bb; } }
#pragma unroll
        for (int s2 = 0; s2 < 2; ++s2) if (ok[s2]) { const int r = r0 + s2, b = r / TPB, t = r - b * TPB;
            if (last) {
#pragma unroll
                for (int j = 0; j < 4; ++j) { if (DRY) st4h(Xw + (size_t)r * DM + 4 * lane + 256 * j, v[s2][j]); else *(v4f*)(p->out + ((size_t)b * SEQ + (t - CTXL)) * DM + 4 * lane + 256 * j) = v[s2][j]; }
            } else { const float* mn = mdp[s2] + 5 * 6144;
#pragma unroll
                for (int j = 0; j < 4; ++j) { const int col = 4 * lane + 256 * j; st4h(Xw + (size_t)r * DM + col, v[s2][j]);
                    const v4f sh = *(const v4f*)(mn + col), s1 = *(const v4f*)(mn + 1024 + col); const v4f hv = v[s2][j] * (1.f + s1) + sh;
                    v2u w; w.x = pk2(hv[0], hv[1]); w.y = pk2(hv[2], hv[3]); *(v2u*)(H + (size_t)r * DM + col) = w; } } }
    }
}
#ifndef PROBE
#define PROBE 0
#endif
#ifndef REPEAT_PH
#define REPEAT_PH -1
#endif
__device__ __forceinline__ void dump_f32(KP p, const float* src, size_t n) { const int tid = opaque_tid(); for (size_t i = (size_t)OB() * NTHREADS + tid; i < (size_t)16777216; i += (size_t)OG() * NTHREADS) { float s = 0.f; for (size_t j = i; j < n; j += 16777216) s += src[j]; p->out[i] = s; } }
__device__ __forceinline__ void dump_bf16(KP p, const u16* src, size_t n) { const int tid = opaque_tid(); for (size_t i = (size_t)OB() * NTHREADS + tid; i < (size_t)16777216; i += (size_t)OG() * NTHREADS) { float s = 0.f; for (size_t j = i; j < n; j += 16777216) s += bf2f(src[j]); p->out[i] = s; } }
#define PROBE_F32(k, off, n) if constexpr (PROBE == (k)) { if (l == 0) { GRID_BAR(); dump_f32(kparams(), (const float*)(kparams()->ws + (off)), (size_t)(n)); return; } }
#define PROBE_BF16(k, off, n) if constexpr (PROBE == (k)) { if (l == 0) { GRID_BAR(); dump_bf16(kparams(), (const u16*)(kparams()->ws + (off)), (size_t)(n)); return; } }
__global__ void __launch_bounds__(NTHREADS, 2) fwd_kernel(Params p_arg) {
    extern __shared__ __attribute__((aligned(16))) unsigned char shm[];
    const int tid = opaque_tid();
    LAS unsigned char* ldsp = (LAS unsigned char*)shm;
    volatile LAS unsigned* misc = (volatile LAS unsigned*)(ldsp + LDS_MISC);
    if (tid < 64) misc[tid] = 0u;
    __syncthreads();
    (void)xcd_barrier_post((unsigned*)(p_arg.ws + WS_CTL) + CW_BAR, misc + 8);
#define GRID_BAR() do { XcdBarrier b_; b_.bar = (unsigned*)(kparams()->ws + WS_CTL) + CW_BAR; b_.x = xb_xcc_id(); b_.st = misc + 8; xcd_barrier(b_); } while (0)
    unsigned char* smem = shm;
    int* tileE = (int*)(shm + LDS_MISC + 1024); int* mbase = (int*)(shm + LDS_MISC + 2048); int* cntl = (int*)(shm + LDS_MISC + 2304); int* nTp = (int*)(shm + LDS_MISC + 2432); int* qslot = (int*)(shm + LDS_MISC + 2560);

#ifndef GEMM_ALIGN
#define GEMM_ALIGN true
#endif
#ifndef GEMM_SP2
#define GEMM_SP2 true
#endif
#ifndef PHMASK
#define PHMASK 0xFFFF
#endif
#define PH(k) if constexpr ((PHMASK >> (k)) & 1)
    PH(0) p0_prologue(kparams(), smem);
    GRID_BAR();
    PH(1) p0b_init(kparams());
    { const int l = 0; PROBE_F32(1, WS_X, (size_t)NTOK * 1024) }
    GRID_BAR();

#ifdef UNROLL_LAYERS
#pragma unroll
#endif
    for (int l = 0; l < DEPTH; ++l) {
        PH(2) { KP p = kparams(); const float* TABf = (const float*)(p->ws + WS_TAB); pg8::Gemm g{(const pg8::bf16_t*)(p->ws + WS_H), (const pg8::bf16_t*)(p->ws + WS_WIN), NTOK, INC, DM};
          pg8::StaticOrder S; S.init(NTOK, INC, OG(), OB());
          EpiIn E{(u16*)(p->ws + WS_PB), (u16*)(p->ws + WS_LF), TABf + TAB_LB / 4 + l * 1024, TABf + TAB_ROPE / 4};
          pg8::gemm_phase<EpiIn, pg8::StaticOrder, GEMM_ALIGN, GEMM_SP2>(ldsp, g, S, E); }
        if constexpr (REPEAT_PH == 22) { GRID_BAR(); { KP p = kparams(); pg8::Gemm g{(const pg8::bf16_t*)(p->ws + WS_H), (const pg8::bf16_t*)(p->ws + WS_WIN), NTOK, INC, DM};
          pg8::StaticOrder S; S.init(NTOK, INC, OG(), OB()); EpiPlainDummy E{(u16*)(p->ws + WS_SB), PBC};
          pg8::gemm_phase<EpiPlainDummy, pg8::StaticOrder, GEMM_ALIGN, GEMM_SP2>(ldsp, g, S, E); } }
        if constexpr (REPEAT_PH == 2) { GRID_BAR(); { KP p = kparams(); const float* TABf = (const float*)(p->ws + WS_TAB); pg8::Gemm g{(const pg8::bf16_t*)(p->ws + WS_H), (const pg8::bf16_t*)(p->ws + WS_WIN), NTOK, INC, DM};
          pg8::StaticOrder S; S.init(NTOK, INC, OG(), OB());
          EpiIn E{(u16*)(p->ws + WS_PB), (u16*)(p->ws + WS_LF), TABf + TAB_LB / 4 + l * 1024, TABf + TAB_ROPE / 4};
          pg8::gemm_phase<EpiIn, pg8::StaticOrder, GEMM_ALIGN, GEMM_SP2>(ldsp, g, S, E); } }
        PROBE_BF16(2, WS_PB, (size_t)NTOK * PBC) PROBE_F32(12, WS_LF, (size_t)NTOK * 1024)
        GRID_BAR();
        PH(3) sc1_phase(kparams(), l, smem, qslot);
        if constexpr (REPEAT_PH == 3) { GRID_BAR(); sc1_phase(kparams(), l, smem, qslot); }
        PROBE_BF16(3, WS_SB, (size_t)2176 * 16384) PROBE_BF16(13, WS_RB, (size_t)2176 * 4096) PROBE_F32(23, WS_E, (size_t)128 * 272 * 128) PROBE_F32(33, WS_SA, (size_t)2176 * 128)
        GRID_BAR();
        PH(4) sc2_phase(kparams(), l, smem);
        PROBE_BF16(4, WS_SB, (size_t)2176 * 16384) PROBE_BF16(14, WS_RB, (size_t)2176 * 4096) PROBE_BF16(24, WS_HS, (size_t)128 * 272 * 128)
        GRID_BAR();
        PH(5) sc3_phase<4>(kparams(), l, smem, qslot, 0);
        GRID_BAR();
        PH(6) { KP p = kparams(); int kglu = 256; asm volatile("" : "+s"(kglu)); pg8::Gemm g{(const pg8::bf16_t*)(p->ws + WS_S5G), (const pg8::bf16_t*)(p->ws + WS_GLUW) + (size_t)l * 256 * 256, NTOK, 256, kglu};
          pg8::StaticOrder S; S.init(NTOK, 256, OG(), OB());
          EpiGlu E{(const u16*)(p->ws + WS_S5G), (u16*)(p->ws + WS_MX), p->in[21] + l * 256};
          pg8::gemm_phase<EpiGlu, pg8::StaticOrder, GEMM_ALIGN, GEMM_SP2>(ldsp, g, S, E); }
        __syncthreads();
        PH(5) sc3_phase<3>(kparams(), l, smem, qslot, l * 128);
        GRID_BAR();
        if constexpr (REPEAT_PH == 7) { { KP p = kparams(); const float* TABf = (const float*)(p->ws + WS_TAB); pg8::Gemm g{(const pg8::bf16_t*)(p->ws + WS_MX), (const pg8::bf16_t*)(p->ws + ((l & 1) ? WS_WOUT2 : WS_WOUT)), NTOK, DM, DM};
          LatOrder S; S.init(NTOK, DM, OG(), OB(), l == DEPTH - 1);
          EpiOut E{(const u16*)(p->ws + WS_X), (u16*)(p->ws + WS_PB), TABf + TAB_MOD / 4 + (size_t)l * 5 * 6144};
          pg8::gemm_phase<EpiOut, LatOrder, GEMM_ALIGN, GEMM_SP2>(ldsp, g, S, E); } GRID_BAR(); }
        PH(7) { KP p = kparams(); const float* TABf = (const float*)(p->ws + WS_TAB); pg8::Gemm g{(const pg8::bf16_t*)(p->ws + WS_MX), (const pg8::bf16_t*)(p->ws + ((l & 1) ? WS_WOUT2 : WS_WOUT)), NTOK, DM, DM};
          LatOrder S; S.init(NTOK, DM, OG(), OB(), l == DEPTH - 1);
          EpiOut E{(const u16*)(p->ws + WS_X), (u16*)(p->ws + WS_X), TABf + TAB_MOD / 4 + (size_t)l * 5 * 6144};
          pg8::gemm_phase<EpiOut, LatOrder, GEMM_ALIGN, GEMM_SP2>(ldsp, g, S, E);
          __syncthreads(); conv_tail(kparams(), l, smem); }
        PROBE_F32(7, WS_X, (size_t)NTOK * 1024)
        GRID_BAR();
        if constexpr (REPEAT_PH == 8) { ln1_phase<true>(kparams(), l, smem); GRID_BAR(); }
        PH(8) ln1_phase(kparams(), l, smem);
        PROBE_F32(8, WS_X, (size_t)NTOK * 1024)
        GRID_BAR();
        PH(9) gather_phase(kparams(), l, cntl, mbase, tileE, nTp);
        if constexpr (REPEAT_PH == 9) { GRID_BAR(); gather_phase(kparams(), l, cntl, mbase, tileE, nTp); }
        if constexpr (REPEAT_PH == 20) { GRID_BAR(); GRID_BAR(); GRID_BAR(); GRID_BAR(); }
        GRID_BAR();
        PH(10) { KP p = kparams(); moe_tables(p, l, cntl, mbase, tileE, nTp);
          pg8::Gemm g{(const pg8::bf16_t*)(p->ws + WS_HSORT), (const pg8::bf16_t*)(p->ws + WS_WGU), MOEROWS, 16 * 1024, DM};
          MoeOrder S{tileE, *nTp, OG(), OB()};
          EpiGU E{(u16*)(p->ws + WS_HID)};
          pg8::gemm_phase<EpiGU, MoeOrder, GEMM_ALIGN, GEMM_SP2>(ldsp, g, S, E); }
        GRID_BAR();
        PH(11) { KP p = kparams(); pg8::Gemm g{(const pg8::bf16_t*)(p->ws + WS_HID), (const pg8::bf16_t*)(p->ws + WS_WDN), MOEROWS, 16 * 1024, 512};
          MoeOrder S{tileE, *nTp, OG(), OB()};
          EpiDown E{(u16*)(p->ws + WS_Y2), (const int*)(p->ws + WS_ROUTE + RT_RINFO), (const float*)(p->ws + WS_ROUTE + RT_ROWW)};
          pg8::gemm_phase<EpiDown, MoeOrder, GEMM_ALIGN, GEMM_SP2>(ldsp, g, S, E); }
        GRID_BAR();
        if constexpr (REPEAT_PH == 12) { ln2_phase<true>(kparams(), l); GRID_BAR(); }
        PH(12) ln2_phase(kparams(), l);
        PROBE_F32(10, WS_X, (size_t)NTOK * 1024)
        if (l < DEPTH - 1) GRID_BAR();
    }
}

extern "C" void kernel_launch(void* const* d_in, const int* in_sizes, int n_in, void* d_out, int out_size, void* d_ws, size_t ws_size, hipStream_t stream) {
    static int grid = 0;
    if (grid == 0) {
        if (n_in != 34 || ws_size < WS_END) { fprintf(stderr, "kernel_launch: unexpected n_in %d or ws %zu < %zu\n", n_in, ws_size, (size_t)WS_END); grid = -1; return; }
        int dev = 0, cus = 0, per_cu = 0;
        if (hipGetDevice(&dev) != hipSuccess || hipDeviceGetAttribute(&cus, hipDeviceAttributeMultiprocessorCount, dev) != hipSuccess) { grid = -1; return; }
        if (hipFuncSetAttribute((const void*)fwd_kernel, hipFuncAttributeMaxDynamicSharedMemorySize, LDS_BYTES) != hipSuccess) { fprintf(stderr, "kernel_launch: hipFuncSetAttribute failed\n"); grid = -1; return; }
        if (hipOccupancyMaxActiveBlocksPerMultiprocessor(&per_cu, (const void*)fwd_kernel, NTHREADS, LDS_BYTES) != hipSuccess || per_cu < 1) { fprintf(stderr, "kernel_launch: occupancy query says %d\n", per_cu); }
        (void)hipGetLastError();
        grid = cus;
    }
    if (grid < 0) return;
    (void)in_sizes; (void)out_size;
    if (hipMemsetAsync((char*)d_ws + WS_CTL, 0, CTL_BYTES, stream) != hipSuccess) { fprintf(stderr, "kernel_launch: memset failed\n"); return; }
    Params p{};
    for (int i = 0; i < 34; ++i) p.in[i] = (const float*)d_in[i];
    p.out = (float*)d_out; p.ws = (unsigned char*)d_ws;
    hipLaunchKernelGGL(fwd_kernel, dim3(grid), dim3(NTHREADS), LDS_BYTES, stream, p);
}
```
